# Optimizing an MI355X kernel written in HIP

```python
import jax, jax.numpy as jnp
from jax import lax
import numpy as np

D_MODEL = 1024
BATCH = 16
SEQ = 4096
DEPTH = 4

N_A_LAYERS = DEPTH // 2
N_B_LAYERS = DEPTH - N_A_LAYERS
POOL_WINDOWS = (2, 4, 8, 16)
N_POOL_GROUPS = len(POOL_WINDOWS)
POOL_GROUP_DIM = D_MODEL // N_POOL_GROUPS
QK_NOPE_DIM = 128
QK_ROPE_DIM = 64
V_HEAD_DIM = 128
N_HEADS = D_MODEL // 128
Q_LORA_RANK = D_MODEL // 2
KV_LORA_RANK = D_MODEL // 4
ROPE_THETA = 10000.0
D_FF = 4 * D_MODEL
Q_BLOCK = 128
N_MOD = 6
DEEPNORM_ALPHA = (2.0 * DEPTH) ** 0.25
DEEPNORM_BETA = (8.0 * DEPTH) ** -0.25
LN_EPS = 1e-5
RMS_EPS = 1e-6
MAX_START = 1024
ATTN_SCALE = (QK_NOPE_DIM + QK_ROPE_DIM) ** -0.5

kernel_name = "yoco_pool_mla_deepnorm_adaln"


def layer_norm(x, g, b):
    xf = x.astype(jnp.float32)
    mu = jnp.mean(xf, axis=-1, keepdims=True)
    xc = xf - mu
    var = jnp.mean(xc * xc, axis=-1, keepdims=True)
    return (xc * lax.rsqrt(var + LN_EPS) * g + b).astype(x.dtype)


def rms_norm(x, g):
    xf = x.astype(jnp.float32)
    ms = jnp.mean(xf * xf, axis=-1, keepdims=True)
    return (xf * lax.rsqrt(ms + RMS_EPS) * g).astype(x.dtype)


def rope(x, cos, sin):
    x1, x2 = jnp.split(x, 2, axis=-1)
    return jnp.concatenate([x1 * cos - x2 * sin, x2 * cos + x1 * sin], axis=-1)


def modulate(x, shift, scale):
    return x * (1.0 + scale[:, None, :]) + shift[:, None, :]


def causal_multiscale_pool(h):
    b, s, d = h.shape
    hf = h.astype(jnp.float32)
    cs = jnp.cumsum(hf, axis=1)
    t = jnp.arange(s)
    outs = []
    for g, w in enumerate(POOL_WINDOWS):
        csg = cs[..., g * POOL_GROUP_DIM:(g + 1) * POOL_GROUP_DIM]
        shifted = jnp.pad(csg[:, :s - w], ((0, 0), (w, 0), (0, 0)))
        cnt = jnp.minimum(t + 1, w).astype(jnp.float32)[None, :, None]
        outs.append((csg - shifted) / cnt)
    pooled = jnp.concatenate(outs, axis=-1)
    return (pooled - hf).astype(h.dtype)


def pool_mixer(h, w_pool, scale):
    b, s, d = h.shape
    y = causal_multiscale_pool(h).reshape(b, s, N_POOL_GROUPS, POOL_GROUP_DIM)
    y = jnp.einsum('bsgc,gcd->bsgd', y, w_pool).reshape(b, s, d)
    return y * scale


def sq_relu_mlp(h, w1, w2):
    a = jax.nn.relu(h @ w1)
    return (a * a) @ w2


def shared_kv(x, kv_in_w, kv_norm_g, k_up_w, v_up_w, cos, sin):
    b, s, _ = x.shape
    ckr = x @ kv_in_w
    c_kv = rms_norm(ckr[..., :KV_LORA_RANK], kv_norm_g)
    k_rope = rope(ckr[..., KV_LORA_RANK:], cos, sin)
    k_nope = (c_kv @ k_up_w).reshape(b, s, N_HEADS, QK_NOPE_DIM)
    v = (c_kv @ v_up_w).reshape(b, s, N_HEADS, V_HEAD_DIM)
    return k_nope, k_rope, v


def mla_attention(h, q_down_w, q_norm_g, q_up_w, out_w, k_nope, k_rope, v, cos, sin):
    b, s, _ = h.shape
    cq = rms_norm(h @ q_down_w, q_norm_g)
    q = (cq @ q_up_w).reshape(b, s, N_HEADS, QK_NOPE_DIM + QK_ROPE_DIM)
    q_nope = q[..., :QK_NOPE_DIM]
    q_rope = rope(q[..., QK_NOPE_DIM:], cos[:, :, None, :], sin[:, :, None, :])
    nb = s // Q_BLOCK
    qn = q_nope.reshape(b, nb, Q_BLOCK, N_HEADS, QK_NOPE_DIM).transpose(1, 0, 2, 3, 4)
    qr = q_rope.reshape(b, nb, Q_BLOCK, N_HEADS, QK_ROPE_DIM).transpose(1, 0, 2, 3, 4)
    kpos = jnp.arange(s)

    def one_block(args):
        qn_b, qr_b, i = args
        sc = (jnp.einsum('bqhd,bkhd->bhqk', qn_b, k_nope)
              + jnp.einsum('bqhr,bkr->bhqk', qr_b, k_rope)).astype(jnp.float32) * ATTN_SCALE
        qpos = i * Q_BLOCK + jnp.arange(Q_BLOCK)
        mask = kpos[None, :] <= qpos[:, None]
        sc = jnp.where(mask[None, None], sc, -jnp.inf)
        p = jax.nn.softmax(sc, axis=-1).astype(v.dtype)
        return jnp.einsum('bhqk,bkhd->bqhd', p, v)

    o = lax.map(one_block, (qn, qr, jnp.arange(nb)))
    o = o.transpose(1, 0, 2, 3, 4).reshape(b, s, N_HEADS * V_HEAD_DIM)
    return o @ out_w


def setup_inputs(seed: int = 0) -> dict:
    key = jax.random.key(seed)
    ks = jax.random.split(key, 20)
    n = jax.random.normal
    f32 = jnp.float32
    D = D_MODEL
    qk_dim = QK_NOPE_DIM + QK_ROPE_DIM
    start = jax.random.randint(ks[2], (BATCH, 1), 0, MAX_START, dtype=jnp.int32)
    positions = (start + jnp.arange(SEQ, dtype=jnp.int32)[None, :]).astype(jnp.int32)
    return {
        "x": n(ks[0], (BATCH, SEQ, D), f32),
        "c": n(ks[1], (BATCH, D), f32),
        "positions": positions,
        "ada_w": n(ks[3], (DEPTH, D, N_MOD * D), f32) * (0.5 * D ** -0.5),
        "ada_b": 0.01 * n(ks[4], (DEPTH, N_MOD * D), f32),
        "ln_g": 1.0 + 0.02 * n(ks[5], (DEPTH, 2, D), f32),
        "ln_b": 0.02 * n(ks[6], (DEPTH, 2, D), f32),
        "mlp_w1": n(ks[7], (DEPTH, D, D_FF), f32) * D ** -0.5,
        "mlp_w2": n(ks[8], (DEPTH, D_FF, D), f32) * (D_FF ** -0.5 * DEEPNORM_BETA),
        "pool_w": n(ks[9], (N_A_LAYERS, N_POOL_GROUPS, POOL_GROUP_DIM, POOL_GROUP_DIM), f32)
                  * (POOL_GROUP_DIM ** -0.5 * DEEPNORM_BETA),
        "pool_scale": 1.0 + 0.1 * n(ks[10], (N_A_LAYERS, D), f32),
        "q_down_w": n(ks[11], (N_B_LAYERS, D, Q_LORA_RANK), f32) * D ** -0.5,
        "q_norm_g": 1.0 + 0.02 * n(ks[12], (N_B_LAYERS, Q_LORA_RANK), f32),
        "q_up_w": n(ks[13], (N_B_LAYERS, Q_LORA_RANK, N_HEADS * qk_dim), f32) * Q_LORA_RANK ** -0.5,
        "attn_out_w": n(ks[14], (N_B_LAYERS, N_HEADS * V_HEAD_DIM, D), f32)
                      * ((N_HEADS * V_HEAD_DIM) ** -0.5 * DEEPNORM_BETA),
        "kv_in_w": n(ks[15], (D, KV_LORA_RANK + QK_ROPE_DIM), f32) * D ** -0.5,
        "kv_norm_g": 1.0 + 0.02 * n(ks[16], (KV_LORA_RANK,), f32),
        "k_up_w": n(ks[17], (KV_LORA_RANK, N_HEADS * QK_NOPE_DIM), f32) * KV_LORA_RANK ** -0.5,
        "v_up_w": n(ks[18], (KV_LORA_RANK, N_HEADS * V_HEAD_DIM), f32)
                  * (KV_LORA_RANK ** -0.5 * DEEPNORM_BETA),
    }


def reference(x, c, positions, ada_w, ada_b, ln_g, ln_b, mlp_w1, mlp_w2, pool_w, pool_scale,
              q_down_w, q_norm_g, q_up_w, attn_out_w, kv_in_w, kv_norm_g, k_up_w, v_up_w):
    b, s, d = x.shape
    mod = (jnp.einsum('bd,ldm->blm', jax.nn.silu(c), ada_w) + ada_b[None]).reshape(b, DEPTH, N_MOD, d)
    inv_freq = ROPE_THETA ** (-jnp.arange(0, QK_ROPE_DIM, 2, dtype=jnp.float32) / QK_ROPE_DIM)
    ang = positions.astype(jnp.float32)[..., None] * inv_freq
    cos = jnp.cos(ang).astype(x.dtype)
    sin = jnp.sin(ang).astype(x.dtype)

    for l in range(DEPTH):
        shift1, scale1, gate1 = mod[:, l, 0], mod[:, l, 1], mod[:, l, 2]
        shift2, scale2, gate2 = mod[:, l, 3], mod[:, l, 4], mod[:, l, 5]
        h = modulate(x, shift1, scale1)
        if l < N_A_LAYERS:
            y = pool_mixer(h, pool_w[l], pool_scale[l])
        else:
            if l == N_A_LAYERS:
                k_nope, k_rope, v = shared_kv(x, kv_in_w, kv_norm_g, k_up_w, v_up_w, cos, sin)
            j = l - N_A_LAYERS
            y = mla_attention(h, q_down_w[j], q_norm_g[j], q_up_w[j], attn_out_w[j],
                              k_nope, k_rope, v, cos, sin)
        x = layer_norm(DEEPNORM_ALPHA * x + gate1[:, None, :] * y, ln_g[l, 0], ln_b[l, 0])
        h = modulate(x, shift2, scale2)
        y = sq_relu_mlp(h, mlp_w1[l], mlp_w2[l])
        x = layer_norm(DEEPNORM_ALPHA * x + gate2[:, None, :] * y, ln_g[l, 1], ln_b[l, 1])
    return x
```

```cpp
#include <hip/hip_runtime.h>
#include <hip/hip_cooperative_groups.h>
#include <cstdio>
#include <cstdint>
namespace cg = cooperative_groups;

namespace pg8 {
#define PG8_LAS __attribute__((address_space(3)))
typedef unsigned short bf16_t;
typedef short bf16x8 __attribute__((ext_vector_type(8)));
typedef float f32x4 __attribute__((ext_vector_type(4)));
typedef float f32x2 __attribute__((ext_vector_type(2)));
typedef unsigned u32x4 __attribute__((ext_vector_type(4)));
typedef unsigned u32x2 __attribute__((ext_vector_type(2)));
constexpr int BM = 256, BK = 64, HALF = 128, HTB = HALF * BK * 2  , STAGE_BYTES = 8 * HTB, NXCD = 8, WGM = 8;

__host__ __device__ __forceinline__ int lds_byte(int r, int c) { const int st = (r >> 4) * 2 + (c >> 5), rr = r & 15, cc = c & 31, ob = rr * 64 + cc * 2; return st * 1024 + (ob ^ (((ob >> 9) & 1) << 5)); }
__host__ __device__ __forceinline__ void stage_rc(int b, int& R, int& C) { const int st = b / 1024, sb = b % 1024, swz = sb ^ (((sb >> 9) & 1) << 5); R = (st >> 1) * 16 + swz / 64; C = (st & 1) * 32 + (swz % 64) / 2; }
__host__ __device__ __forceinline__ int perm32(int rho) { const int n = rho >> 4, i = rho & 15; return 8 * (i >> 2) + 4 * n + (i & 3); }

struct Unit { int pm, pn; };
struct Gemm { const bf16_t* A; const bf16_t* Bt; int M, N, K, lda; size_t a_pn_off; };

struct StaticOrder {
    int nM, nN, nwg, G, c;
    __host__ __device__ void init(int M, int N, int G_, int c_) { nM = M / BM; nN = N / BM; nwg = nM * nN; G = G_; c = c_; }
    __host__ __device__ bool next(int i, Unit& u) const {
        const long L = (long)i * G + c; if (L >= nwg) return false;
        int wgid = (int)L; { const int q = nwg / NXCD, r = nwg % NXCD, xcd = wgid % NXCD, off = wgid / NXCD; wgid = (xcd < r ? xcd * (q + 1) : r * (q + 1) + (xcd - r) * q) + off; }
        const int nig = WGM * nN, gid = wgid / nig, fm = gid * WGM, gsz = (nM - fm) < WGM ? (nM - fm) : WGM;
        u.pm = fm + ((wgid % nig) % gsz); u.pn = (wgid % nig) / gsz; return true;
    }
    __device__ __forceinline__ void a_ready(const Unit&) const {}
    __device__ __forceinline__ void done(const Unit&) const {}
};

#define EPI_IDS() int t_ = threadIdx.x; asm volatile("" : "+v"(t_)); const int w_ = __builtin_amdgcn_readfirstlane(t_ >> 6), wr = w_ >> 2, wc = w_ & 3, fr = t_ & 15, fq = (t_ & 63) >> 4; (void)wr_; (void)wc_; (void)fr_; (void)fq_
__device__ __forceinline__ unsigned cvt_pk_bf16(float lo, float hi) { unsigned r; asm volatile("v_cvt_pk_bf16_f32 %0, %1, %2" : "=v"(r) : "v"(lo), "v"(hi)); return r; }

template <int ACT> struct EpiBf16 {
    static constexpr bool PERM = true, AFTER_DRAIN = false;
    bf16_t* O; int ldc;
    __device__ __forceinline__ void operator()(const f32x4 (&acc)[2][2][4][2], const Unit& u, int wr_, int wc_, int fr_, int fq_) const {
        EPI_IDS();
        const int row0 = u.pm * BM + wr * 64 + fr; const int col0 = u.pn * BM + wc * 32 + 8 * fq;
#pragma unroll
        for (int ai = 0; ai < 2; ++ai)
#pragma unroll
            for (int m = 0; m < 4; ++m) { bf16_t* rowp = O + (size_t)(row0 + ai * HALF + m * 16) * ldc + col0;
#pragma unroll
                for (int bj = 0; bj < 2; ++bj) { f32x4 v0 = acc[ai][bj][m][0], v1 = acc[ai][bj][m][1];
                    if (ACT == 1) {
#pragma unroll
                        for (int e = 0; e < 4; ++e) { const float a = fmaxf(v0[e], 0.f), b = fmaxf(v1[e], 0.f); v0[e] = a * a; v1[e] = b * b; } }
                    u32x4 w; w.x = cvt_pk_bf16(v0[0], v0[1]); w.y = cvt_pk_bf16(v0[2], v0[3]); w.z = cvt_pk_bf16(v1[0], v1[1]); w.w = cvt_pk_bf16(v1[2], v1[3]);
                    *(u32x4*)(rowp + bj * HALF) = w; } }
    }
};

template <int MODE2> struct EpiHead {
    static constexpr bool PERM = true, AFTER_DRAIN = false;
    bf16_t* O1; bf16_t* O2; const float* rscale; const float* cs;
    __device__ __forceinline__ void operator()(const f32x4 (&acc)[2][2][4][2], const Unit& u, int wr_, int wc_, int fr_, int fq_) const {
        EPI_IDS();
        const int row0 = u.pm * BM + wr * 64 + fr;
#pragma unroll
        for (int ai = 0; ai < 2; ++ai)
#pragma unroll
            for (int m = 0; m < 4; ++m) { const int row = row0 + ai * HALF + m * 16; const float rs = rscale[row];
#pragma unroll
                for (int bj = 0; bj < 2; ++bj) { const f32x4 v0 = acc[ai][bj][m][0] * rs, v1 = acc[ai][bj][m][1] * rs;
                    if (u.pn < 4) {
                        u32x4 w; w.x = cvt_pk_bf16(v0[0], v0[1]); w.y = cvt_pk_bf16(v0[2], v0[3]); w.z = cvt_pk_bf16(v1[0], v1[1]); w.w = cvt_pk_bf16(v1[2], v1[3]);
                        *(u32x4*)(O1 + (size_t)row * 1536 + (u.pn * 2 + bj) * 192 + wc * 32 + 8 * fq) = w;
                    } else if (MODE2 == 0) {
                        u32x4 w; w.x = cvt_pk_bf16(v0[0], v0[1]); w.y = cvt_pk_bf16(v0[2], v0[3]); w.z = cvt_pk_bf16(v1[0], v1[1]); w.w = cvt_pk_bf16(v1[2], v1[3]);
                        *(u32x4*)(O2 + (size_t)row * 1024 + (u.pn - 4) * BM + bj * HALF + wc * 32 + 8 * fq) = w;
                    } else {
                        const int head = (u.pn - 4) * 4 + bj * 2 + (wc >> 1), i0 = ((wc & 1) * 4 + fq) * 4;
                        const f32x4 c0 = *(const f32x4*)(cs + ((size_t)row * 32 + i0) * 2), c1 = *(const f32x4*)(cs + ((size_t)row * 32 + i0) * 2 + 4);
                        const float o10 = v0[0] * c0[0] - v1[0] * c0[1], o20 = v1[0] * c0[0] + v0[0] * c0[1];
                        const float o11 = v0[1] * c0[2] - v1[1] * c0[3], o21 = v1[1] * c0[2] + v0[1] * c0[3];
                        const float o12 = v0[2] * c1[0] - v1[2] * c1[1], o22 = v1[2] * c1[0] + v0[2] * c1[1];
                        const float o13 = v0[3] * c1[2] - v1[3] * c1[3], o23 = v1[3] * c1[2] + v0[3] * c1[3];
                        bf16_t* dst = O1 + (size_t)row * 1536 + head * 192 + 128 + i0;
                        u32x2 w1, w2; w1.x = cvt_pk_bf16(o10, o11); w1.y = cvt_pk_bf16(o12, o13); w2.x = cvt_pk_bf16(o20, o21); w2.y = cvt_pk_bf16(o22, o23);
                        *(u32x2*)dst = w1; *(u32x2*)(dst + 32) = w2;
                    } } }
    }
};

struct EpiRes {
    static constexpr bool PERM = false, AFTER_DRAIN = false;
    const float* zin; float* zout; const float* stats; const float* lng; const float* lnb; const float* gate  ; const float* gmul; int row_base; float alpha;
    __device__ __forceinline__ void operator()(const f32x4 (&acc)[2][2][4][2], const Unit& u, int wr_, int wc_, int fr_, int fq_) const {
        EPI_IDS();
        const int col0 = u.pn * BM + wc * 32 + 4 * fq; const int rt0 = row_base + u.pm * BM; const int b = rt0 >> 12;
        f32x4 gv[2][2], lg[2][2], lb[2][2];
#pragma unroll
        for (int bj = 0; bj < 2; ++bj)
#pragma unroll
            for (int n = 0; n < 2; ++n) { const int c = col0 + bj * HALF + n * 16; f32x4 g = *(const f32x4*)(gate + (size_t)b * 24576 + c);
                if (gmul) g = g * *(const f32x4*)(gmul + c); gv[bj][n] = g;
                if (stats) { lg[bj][n] = *(const f32x4*)(lng + c); lb[bj][n] = *(const f32x4*)(lnb + c); } else { lg[bj][n] = (f32x4){1.f, 1.f, 1.f, 1.f}; lb[bj][n] = (f32x4){0.f, 0.f, 0.f, 0.f}; } }
#pragma unroll
        for (int ai = 0; ai < 2; ++ai)
#pragma unroll
            for (int m = 0; m < 4; ++m) { const int r = rt0 + ai * HALF + wr * 64 + m * 16 + fr; float mu = 0.f, rstd = 1.f;
                if (stats) { const f32x2 s = *(const f32x2*)(stats + (size_t)r * 2); mu = s.x; rstd = s.y; }
                const size_t off = (size_t)r * 1024 + col0;
#pragma unroll
                for (int bj = 0; bj < 2; ++bj)
#pragma unroll
                    for (int n = 0; n < 2; ++n) { const f32x4 zi = *(const f32x4*)(zin + off + bj * HALF + n * 16);
                        const f32x4 x = (zi - mu) * rstd * lg[bj][n] + lb[bj][n];
                        *(f32x4*)(zout + off + bj * HALF + n * 16) = x * alpha + gv[bj][n] * acc[ai][bj][m][n]; }
                if (m & 1) asm volatile("" ::: "memory"); }
    }
};

template <class Epi, class Sched, bool ALIGN_EPI = false, bool SP2 = false>
__device__ __forceinline__ void gemm_phase(PG8_LAS unsigned char* lds, const Gemm g, const Sched& S, const Epi& E) {
    int tid_ = threadIdx.x; asm volatile("" : "+v"(tid_));
    const int tid = tid_, wid = __builtin_amdgcn_readfirstlane(tid >> 6), lane = tid & 63, wr = wid >> 2, wc = wid & 3, fr = lane & 15, fq = lane >> 4;
    const int K = g.K, nt = K / BK;
    unsigned voffA[2], voffB[2];
#pragma unroll
    for (int i = 0; i < 2; ++i) { int R, C; stage_rc(tid * 16 + i * 8192, R, C); const int Rb = Epi::PERM ? ((R & ~31) + perm32(R & 31)) : R;
        voffA[i] = (unsigned)(R * g.lda + C) * 2u; voffB[i] = (unsigned)(Rb * K + C) * 2u; }
    const size_t kstep = (size_t)(BK * 2);
    const size_t hstepA = (size_t)HALF * g.lda * 2, hstepB = (size_t)HALF * K * 2;
    const size_t tstepA = 2 * hstepA, tstepB = 2 * hstepB;
    const unsigned ldsw = (unsigned)wid * 1024u;
    const int aoff = lds_byte(wr * 64 + fr, fq * 8), boff = lds_byte(wc * 32 + fr, fq * 8);
#define PG8_SA(b, h) (((b) * 2 + (h)) * HTB)
#define PG8_SB(b, h) ((4 + (b) * 2 + (h)) * HTB)
#define PG8_STAGE(bufoff, gbase, voff) do { _Pragma("unroll") for (int _i = 0; _i < 2; ++_i) \
        __builtin_amdgcn_global_load_lds((const unsigned*)((const char*)(gbase) + (voff)[_i]), (PG8_LAS unsigned*)(lds + (bufoff) + ldsw + _i * 8192), 16, 0, 0); } while (0)
#define PG8_LDA(dst, b, h) do { _Pragma("unroll") for (int m = 0; m < 4; ++m) _Pragma("unroll") for (int k = 0; k < 2; ++k) dst[m][k] = *(const PG8_LAS bf16x8*)(lds + PG8_SA(b, h) + aoff + m * 2048 + k * 1024); } while (0)
#define PG8_LDB(dst, b, h) do { _Pragma("unroll") for (int n = 0; n < 2; ++n) _Pragma("unroll") for (int k = 0; k < 2; ++k) dst[n][k] = *(const PG8_LAS bf16x8*)(lds + PG8_SB(b, h) + boff + n * 2048 + k * 1024); } while (0)
#define PG8_MMA(ai, bj, At, Bt) do { __builtin_amdgcn_s_setprio(1); _Pragma("unroll") for (int m = 0; m < 4; ++m) _Pragma("unroll") for (int n = 0; n < 2; ++n) _Pragma("unroll") for (int k = 0; k < 2; ++k) \
        acc[ai][bj][m][n] = __builtin_amdgcn_mfma_f32_16x16x32_bf16(Bt[n][k], At[m][k], acc[ai][bj][m][n], 0, 0, 0); __builtin_amdgcn_s_setprio(0); } while (0)
#define PG8_WAIT_V(n) asm volatile("s_waitcnt vmcnt(" #n ")" ::: "memory")
#define PG8_WAIT_L(n) asm volatile("s_waitcnt lgkmcnt(" #n ")" ::: "memory")
#define PG8_BAR __builtin_amdgcn_s_barrier()
#define PG8_SCHED __builtin_amdgcn_sched_barrier(0)
    Unit cur, nxt; int ui = 0;
    if (!S.next(0, cur)) return;
    f32x4 acc[2][2][4][2];
#pragma unroll
    for (int a = 0; a < 2; ++a)
#pragma unroll
        for (int b = 0; b < 2; ++b)
#pragma unroll
            for (int m = 0; m < 4; ++m)
#pragma unroll
                for (int n = 0; n < 2; ++n) acc[a][b][m][n] = (f32x4){0.f, 0.f, 0.f, 0.f};
    bf16x8 At[4][2], B0[2][2], B1[2][2];
    const char* cA = (const char*)g.A + (size_t)cur.pm * tstepA + (size_t)cur.pn * g.a_pn_off; const char* cB = (const char*)g.Bt + (size_t)cur.pn * tstepB;
    S.a_ready(cur);
    if constexpr (SP2) {
        PG8_STAGE(PG8_SB(0, 0), cB, voffB); PG8_STAGE(PG8_SB(0, 1), cB + hstepB, voffB); PG8_STAGE(PG8_SA(0, 0), cA, voffA); PG8_STAGE(PG8_SA(0, 1), cA + hstepA, voffA);
        if (wr == 1) PG8_BAR;
        PG8_WAIT_V(2); PG8_BAR;
        PG8_STAGE(PG8_SB(1, 0), cB + kstep, voffB); PG8_STAGE(PG8_SA(1, 0), cA + kstep, voffA); PG8_STAGE(PG8_SB(1, 1), cB + hstepB + kstep, voffB);
        PG8_WAIT_V(6); PG8_BAR;
    } else {
        PG8_STAGE(PG8_SB(0, 0), cB, voffB); PG8_STAGE(PG8_SA(0, 0), cA, voffA); PG8_STAGE(PG8_SB(0, 1), cB + hstepB, voffB); PG8_STAGE(PG8_SA(0, 1), cA + hstepA, voffA);
        if (wr == 1) PG8_BAR;
        PG8_WAIT_V(4); PG8_BAR;
        PG8_STAGE(PG8_SB(1, 0), cB + kstep, voffB); PG8_STAGE(PG8_SA(1, 0), cA + kstep, voffA); PG8_STAGE(PG8_SB(1, 1), cB + hstepB + kstep, voffB);
        PG8_WAIT_V(6); PG8_BAR;
    }
    for (;;) {
        const bool has_next = S.next(ui + 1, nxt);
        const char* nA = has_next ? (const char*)g.A + (size_t)nxt.pm * tstepA + (size_t)nxt.pn * g.a_pn_off : cA; const char* nB = has_next ? (const char*)g.Bt + (size_t)nxt.pn * tstepB : cB;
        for (int t = 0; t < nt; t += 2) {
            const bool last = (t == nt - 2);
            const char* a1 = cA + (size_t)(t + 1) * kstep;
            const char* a2 = last ? nA : cA + (size_t)(t + 2) * kstep; const char* b2 = last ? nB : cB + (size_t)(t + 2) * kstep;
            const char* a3 = a2 + kstep; const char* b3 = b2 + kstep;
            if (last && has_next) S.a_ready(nxt);
            if constexpr (SP2) {
            PG8_LDB(B0, 0, 0); PG8_LDB(B1, 0, 1); PG8_SCHED; PG8_LDA(At, 0, 0); PG8_STAGE(PG8_SA(1, 1), a1 + hstepA, voffA);
            PG8_WAIT_V(8); PG8_WAIT_L(0); PG8_BAR; PG8_MMA(0, 0, At, B0); PG8_MMA(0, 1, At, B1); PG8_BAR; PG8_SCHED;
            PG8_LDA(At, 0, 1); PG8_STAGE(PG8_SB(0, 0), b2, voffB); PG8_STAGE(PG8_SB(0, 1), b2 + hstepB, voffB); PG8_STAGE(PG8_SA(0, 0), a2, voffA);
            PG8_WAIT_V(8); PG8_WAIT_L(0); PG8_BAR; PG8_MMA(1, 0, At, B0); PG8_MMA(1, 1, At, B1); PG8_BAR; PG8_SCHED;
            PG8_LDB(B0, 1, 0); PG8_LDB(B1, 1, 1); PG8_SCHED; PG8_LDA(At, 1, 0); PG8_STAGE(PG8_SA(0, 1), a2 + hstepA, voffA);
            PG8_WAIT_V(8); PG8_WAIT_L(0); PG8_BAR; PG8_MMA(0, 0, At, B0); PG8_MMA(0, 1, At, B1); PG8_BAR; PG8_SCHED;
            PG8_LDA(At, 1, 1); PG8_STAGE(PG8_SB(1, 0), b3, voffB); PG8_STAGE(PG8_SB(1, 1), b3 + hstepB, voffB); PG8_STAGE(PG8_SA(1, 0), a3, voffA);
            PG8_WAIT_V(8); PG8_WAIT_L(0); PG8_BAR; PG8_MMA(1, 0, At, B0); PG8_MMA(1, 1, At, B1); PG8_BAR; PG8_SCHED;
            } else {
            PG8_LDB(B0, 0, 0); PG8_SCHED; PG8_LDA(At, 0, 0); PG8_STAGE(PG8_SA(1, 1), a1 + hstepA, voffA);
            PG8_WAIT_L(8); PG8_BAR; PG8_WAIT_L(0); PG8_MMA(0, 0, At, B0); PG8_BAR; PG8_SCHED;
            PG8_LDB(B1, 0, 1); PG8_STAGE(PG8_SB(0, 0), b2, voffB);
            PG8_BAR; PG8_WAIT_L(0); PG8_MMA(0, 1, At, B1); PG8_BAR;
            PG8_LDA(At, 0, 1); PG8_STAGE(PG8_SA(0, 0), a2, voffA);
            PG8_BAR; PG8_WAIT_L(0); PG8_MMA(1, 0, At, B0); PG8_BAR; PG8_SCHED;
            PG8_STAGE(PG8_SB(0, 1), b2 + hstepB, voffB);
            PG8_WAIT_V(6); PG8_BAR; PG8_MMA(1, 1, At, B1); PG8_BAR;
            PG8_LDB(B0, 1, 0); PG8_SCHED; PG8_LDA(At, 1, 0); PG8_STAGE(PG8_SA(0, 1), a2 + hstepA, voffA);
            PG8_WAIT_L(8); PG8_BAR; PG8_WAIT_L(0); PG8_MMA(0, 0, At, B0); PG8_BAR; PG8_SCHED;
            PG8_LDB(B1, 1, 1); PG8_STAGE(PG8_SB(1, 0), b3, voffB);
            PG8_BAR; PG8_WAIT_L(0); PG8_MMA(0, 1, At, B1); PG8_BAR;
            PG8_LDA(At, 1, 1); PG8_STAGE(PG8_SA(1, 0), a3, voffA);
            PG8_BAR; PG8_WAIT_L(0); PG8_MMA(1, 0, At, B0); PG8_BAR; PG8_SCHED;
            PG8_STAGE(PG8_SB(1, 1), b3 + hstepB, voffB);
            PG8_WAIT_V(6); PG8_BAR; PG8_MMA(1, 1, At, B1); PG8_BAR;
            }
        }
        if constexpr (ALIGN_EPI) { if (wr == 0) PG8_BAR; }
        if constexpr (!Epi::AFTER_DRAIN) { E(acc, cur, wr, wc, fr, fq); S.done(cur); }
        if (!has_next) break;
#pragma unroll
        for (int a = 0; a < 2; ++a)
#pragma unroll
            for (int b = 0; b < 2; ++b)
#pragma unroll
                for (int m = 0; m < 4; ++m)
#pragma unroll
                    for (int n = 0; n < 2; ++n) acc[a][b][m][n] = (f32x4){0.f, 0.f, 0.f, 0.f};
        cur = nxt; cA = nA; cB = nB; ++ui;
        if constexpr (ALIGN_EPI) { if (wr == 1) PG8_BAR; }
    }
    PG8_WAIT_V(0);
    if constexpr (!ALIGN_EPI) { if (wr == 0) PG8_BAR; }
    PG8_BAR;
    if constexpr (Epi::AFTER_DRAIN) { E.fused(acc, cur, wr, wc, fr, fq, lds, wid, lane); S.done(cur); }
#undef PG8_SA
#undef PG8_SB
#undef PG8_STAGE
#undef PG8_LDA
#undef PG8_LDB
#undef PG8_MMA
#undef PG8_WAIT_V
#undef PG8_WAIT_L
#undef PG8_BAR
#undef PG8_SCHED
}
}

namespace att {
typedef unsigned short bf16;
typedef short bf16x8 __attribute__((ext_vector_type(8)));
typedef short s16x4 __attribute__((ext_vector_type(4)));
typedef float f32x16 __attribute__((ext_vector_type(16)));
typedef float f32x4 __attribute__((ext_vector_type(4)));
typedef unsigned u32x4 __attribute__((ext_vector_type(4)));
constexpr int NW = 8, QBLK = 32, KVBLK = 64, QB = NW * QBLK;
constexpr int QS = 1536, KS = 1536, VS = 1024, OS = 1024;
constexpr int SHM_V = KVBLK * 128 * 2, SHM_K = KVBLK * 192 * 2;
constexpr int QR_OFF = 2 * SHM_V + 2 * SHM_K + NW * 64 * 4;
constexpr int LDS_BYTES = QR_OFF + NW * 4096;
constexpr float SCALE = 0.07216878364870322f;
constexpr float THR = 8.f;

#define KSWZ(row, colB) ((row) * 384 + ((colB) ^ (((row) & 7) << 4)))
#define SBAR() __builtin_amdgcn_sched_barrier(0)
__device__ __forceinline__ int v_st(int k, int c) { const int kk = (k & ~0xC) | ((k & 4) << 1) | ((k & 8) >> 1); return ((kk >> 3) * 4 + (c >> 5)) * 512 + ((kk & 7) * 32 + (c & 31)) * 2; }
__device__ __forceinline__ int v_rd_base(int lane) { return ((lane & 3) << 3) | (((lane >> 2) & 3) << 6) | (((lane >> 4) & 1) << 5) | (((lane >> 5) & 1) << 8); }
constexpr int v_rd_off(int d0, int ks, int half) { return d0 * 512 + ks * 4096 + half * 2048; }
__device__ __forceinline__ int crow(int r, int hi) { return (r & 3) + 8 * (r >> 2) + 4 * hi; }
__device__ __forceinline__ unsigned cvtpk(float lo, float hi) { unsigned r; asm volatile("v_cvt_pk_bf16_f32 %0, %1, %2" : "=v"(r) : "v"(lo), "v"(hi)); return r; }
__device__ __forceinline__ bf16x8 ld8(const bf16* p) { return *reinterpret_cast<const bf16x8*>(p); }
__device__ __forceinline__ void mask_tile(f32x16& p0, f32x16& p1, int dq, unsigned W) {
    const float NEG = -__builtin_inff();
#pragma unroll
    for (int r = 0; r < 16; ++r) {
        const int c = (r & 3) + 8 * (r >> 2);
        if ((unsigned)(dq - c) >= W) p0[r] = NEG;
        if ((unsigned)(dq - c - 32) >= W) p1[r] = NEG;
    }
}
__device__ __forceinline__ void partialSM(f32x16& p0, f32x16& p1, float& m_reg, float& mn, float& alpha) {
    float pmax = p0[0]; for (int r = 1; r < 16; ++r) pmax = fmaxf(pmax, p0[r]); for (int r = 0; r < 16; ++r) pmax = fmaxf(pmax, p1[r]);
    { auto rr = __builtin_amdgcn_permlane32_swap(__float_as_uint(pmax), __float_as_uint(pmax), false, false);
      pmax = fmaxf(__uint_as_float(rr[0]), __uint_as_float(rr[1])); }
    constexpr float C2 = 1.4426950408889634f * SCALE;
    if (__builtin_expect(__all((pmax - m_reg) * SCALE <= THR), 1)) { mn = m_reg; alpha = 1.f; }
    else { mn = fmaxf(m_reg, pmax); alpha = __builtin_amdgcn_exp2f((m_reg - mn) * C2); m_reg = mn; }
    const float mnL = -mn * C2;
    for (int r = 0; r < 16; ++r) p0[r] = fmaf(p0[r], C2, mnL); for (int r = 0; r < 16; ++r) p1[r] = fmaf(p1[r], C2, mnL);
    for (int r = 0; r < 16; ++r) p0[r] = __builtin_amdgcn_exp2f(p0[r]);
}
__device__ __forceinline__ void finishSM(f32x16& p0, f32x16& p1, float alpha, float& l_reg, bf16x8& pa0, bf16x8& pa1, bf16x8& pa2, bf16x8& pa3) {
    for (int r = 0; r < 16; ++r) p1[r] = __builtin_amdgcn_exp2f(p1[r]);
    float ps = 0; for (int r = 0; r < 16; ++r) ps += p0[r]; for (int r = 0; r < 16; ++r) ps += p1[r];
    { auto rr = __builtin_amdgcn_permlane32_swap(__float_as_uint(ps), __float_as_uint(ps), false, false);
      ps = __uint_as_float(rr[0]) + __uint_as_float(rr[1]); }
    l_reg = l_reg * alpha + ps;
#define PK4(P, B_, OUT) do { unsigned a0 = cvtpk(P[B_+0], P[B_+1]), a1 = cvtpk(P[B_+2], P[B_+3]);                          \
        unsigned b0 = cvtpk(P[B_+4], P[B_+5]), b1 = cvtpk(P[B_+6], P[B_+7]);                                             \
        auto r0 = __builtin_amdgcn_permlane32_swap(a0, b0, false, false); auto r1 = __builtin_amdgcn_permlane32_swap(a1, b1, false, false); \
        u32x4 w = {r0[0], r1[0], r0[1], r1[1]}; OUT = *reinterpret_cast<bf16x8*>(&w); } while (0)
    PK4(p0, 0, pa0); PK4(p0, 8, pa1); PK4(p1, 0, pa2); PK4(p1, 8, pa3);
#undef PK4
}
template <int KB>
__device__ __forceinline__ void qkt(f32x16& p0, f32x16& p1, const char* K_lds, int r32, int hi, const bf16x8* qr, const char* qrl) {
    p0 = f32x16{}; p1 = f32x16{};
    const char* kb[4];
#pragma unroll
    for (int dd = 0; dd < 4; ++dd) kb[dd] = K_lds + KB * SHM_K + KSWZ(r32, (dd * 16 + hi * 8) * 2);
#pragma unroll
    for (int d0 = 0; d0 < 12; ++d0) { const char* a = kb[d0 & 3] + (d0 >> 2) * 128;
        bf16x8 b0 = *reinterpret_cast<const bf16x8*>(a);
        bf16x8 b1 = *reinterpret_cast<const bf16x8*>(a + 32 * 384);
        const bf16x8 qd = (d0 < 8) ? qr[d0 < 8 ? d0 : 0] : *reinterpret_cast<const bf16x8*>(qrl + (d0 - 8) * 1024);
        p0 = __builtin_amdgcn_mfma_f32_32x32x16_bf16(b0, qd, p0, 0, 0, 0);
        p1 = __builtin_amdgcn_mfma_f32_32x32x16_bf16(b1, qd, p1, 0, 0, 0);
        if ((d0 & 1) == 1 && d0 != 11) SBAR(); }
}
template <int VB>
__device__ __forceinline__ void pv_tile(f32x16* o, int vb0, bf16x8 pa0, bf16x8 pa1, bf16x8 pa2, bf16x8 pa3) {
#define TRRD(dst, off) asm volatile("ds_read_b64_tr_b16 %0, %1 offset:%2" : "=&v"(dst) : "v"(vb0), "i"(off) : "memory")
#define PV_D0(d0) do { s16x4 l0, l1, l2, l3, h0, h1, h2, h3; constexpr int b_ = VB * SHM_V + v_rd_off(d0, 0, 0);   \
        TRRD(l0, b_); TRRD(h0, b_ + 2048); TRRD(l1, b_ + 4096); TRRD(h1, b_ + 6144); TRRD(l2, b_ + 8192); TRRD(h2, b_ + 10240); TRRD(l3, b_ + 12288); TRRD(h3, b_ + 14336); \
        asm volatile("s_waitcnt lgkmcnt(0)" ::: "memory"); SBAR();                                                        \
        o[d0] = __builtin_amdgcn_mfma_f32_32x32x16_bf16(pa0, (bf16x8){l0[0], l0[1], l0[2], l0[3], h0[0], h0[1], h0[2], h0[3]}, o[d0], 0, 0, 0);   \
        o[d0] = __builtin_amdgcn_mfma_f32_32x32x16_bf16(pa1, (bf16x8){l1[0], l1[1], l1[2], l1[3], h1[0], h1[1], h1[2], h1[3]}, o[d0], 0, 0, 0);   \
        o[d0] = __builtin_amdgcn_mfma_f32_32x32x16_bf16(pa2, (bf16x8){l2[0], l2[1], l2[2], l2[3], h2[0], h2[1], h2[2], h2[3]}, o[d0], 0, 0, 0);   \
        o[d0] = __builtin_amdgcn_mfma_f32_32x32x16_bf16(pa3, (bf16x8){l3[0], l3[1], l3[2], l3[3], h3[0], h3[1], h3[2], h3[3]}, o[d0], 0, 0, 0); } while (0)
    PV_D0(0); PV_D0(1); PV_D0(2); PV_D0(3);
#undef PV_D0
#undef TRRD
}

struct BlockRef { const bf16* Q; const bf16* K; const bf16* V; bf16* O; int P0; };
struct Seam { bf16x8 qr[8]; bf16x8 st_v0, st_v1, st_k0, st_k1, st_k2; };
#define KT(p, k0) ((p) + (size_t)(k0) * KS)
#define VT(p, k0) ((p) + (size_t)(k0) * VS)
#define VMW() asm volatile("s_waitcnt vmcnt(0)" ::: "memory")
#define VMWN(n) asm volatile("s_waitcnt vmcnt(%0)" :: "i"(n) : "memory")
#define SLOAD_H(Kp, Vp, k0) do { const bf16* vt_ = VT(Vp, k0); const bf16* vt2_ = vt_ + 32 * VS; const bf16* kt_ = KT(Kp, k0);                  \
                         S.st_v0 = ld8(vt_ + voff); S.st_v1 = ld8(vt2_ + voff);              \
                         S.st_k0 = ld8(kt_ + koff); S.st_k1 = ld8(kt_ + koff + 64); S.st_k2 = ld8(kt_ + koff + 128); } while (0)
#define SWRITE_HK(bf) do { *(bf16x8*)(K_lds + (bf) * SHM_K + kws) = S.st_k0; *(bf16x8*)(K_lds + (bf) * SHM_K + kws + 128) = S.st_k1; *(bf16x8*)(K_lds + (bf) * SHM_K + kws + 256) = S.st_k2; } while (0)
#define SWRITE_HV(bf) do { *(bf16x8*)(V_lds + (bf) * SHM_V + vst0) = S.st_v0; *(bf16x8*)(V_lds + (bf) * SHM_V + vst1) = S.st_v1; } while (0)
#define SWRITE_H(bf) do { SWRITE_HV(bf); SWRITE_HK(bf); } while (0)
__device__ __forceinline__ void causal_prime(const BlockRef& cur, char* lds, Seam& S) {
    int tid_ = threadIdx.x; asm volatile("" : "+v"(tid_));
    const int tid = tid_, wid = __builtin_amdgcn_readfirstlane(tid >> 6), lane = tid & 63, r32 = lane & 31, hi = lane >> 5;
    const int sr = tid >> 4, sc = (tid & 15) * 8, kr = tid >> 3, kc = (tid & 7) * 8, kws = KSWZ(kr, kc * 2); char* K_lds = lds + 2 * SHM_V;
    const unsigned voff = (unsigned)(sr * VS + sc), koff = (unsigned)(kr * KS + kc), qoff = (unsigned)((wid * QBLK + r32) * QS + hi * 8);
    const int kb0 = 0;
#pragma unroll
    for (int d0 = 0; d0 < 8; ++d0) S.qr[d0] = ld8(cur.Q + qoff + d0 * 16);
    { char* qrl = lds + QR_OFF + wid * 4096 + lane * 16;
#pragma unroll
      for (int d0 = 0; d0 < 4; ++d0) *(bf16x8*)(qrl + d0 * 1024) = ld8(cur.Q + qoff + 128 + d0 * 16); }
    SLOAD_H(cur.K, cur.V, kb0); VMW(); SWRITE_HK(0);
    __syncthreads();
}
__device__ __forceinline__ void causal_block(const BlockRef& cur, const BlockRef& nxt, char* lds, Seam& S) {
    int tid_ = threadIdx.x; asm volatile("" : "+v"(tid_));
    const int tid = tid_, wid = __builtin_amdgcn_readfirstlane(tid >> 6), lane = tid & 63, r32 = lane & 31, hi = lane >> 5;
    constexpr int W = 1 << 30;
    const int NT = (cur.P0 + QB - 1) / KVBLK + 1;
    const int kbn = 0;
    const int qlo = cur.P0 + wid * QBLK, qm = qlo + r32 - 4 * hi;
    char* V_lds = lds; char* K_lds = lds + 2 * SHM_V;
    float* ws = (float*)(lds + 2 * SHM_V + 2 * SHM_K) + wid * 64; float* li_l = ws, * al_l = ws + 32;
    float m_reg = -1e30f, l_reg = 0; f32x16 o[4] = {};
    const int sr = tid >> 4, sc = (tid & 15) * 8, vst0 = v_st(sr, sc), vst1 = v_st(32 + sr, sc);
    const int kr = tid >> 3, kc = (tid & 7) * 8, kws = KSWZ(kr, kc * 2);
    const unsigned voff = (unsigned)(sr * VS + sc), koff = (unsigned)(kr * KS + kc), qoff = (unsigned)((wid * QBLK + r32) * QS + hi * 8);
    const int vb0 = (int)(uintptr_t)V_lds + v_rd_base(lane);
    char* qrl = lds + QR_OFF + wid * 4096 + lane * 16;
    const bf16* Kh = cur.K; const bf16* Vh = cur.V;
#define RESC(a) do { if (__any((a) < 1.f)) { if (hi == 0) al_l[r32] = (a); asm volatile("s_waitcnt lgkmcnt(0)" ::: "memory");              \
                     for (int d_ = 0; d_ < 4; ++d_) for (int r = 0; r < 16; ++r) o[d_][r] *= al_l[crow(r, hi)]; } } while (0)
#define KBASE(t) ((t) * KVBLK)
#define MASKT(P0_, P1_, t) do { const int kb_ = KBASE(t); if (kb_ + KVBLK - 1 > qlo) mask_tile(P0_, P1_, qm - kb_, (unsigned)W); } while (0)
    constexpr int NQL = 8;
#define SEAM_K0() do { VMWN(NQL); SWRITE_HK(0); SBAR(); } while (0)
    f32x16 pA0, pA1, pB0, pB1; float mnA, mnB, alA, alB; bf16x8 pa0, pa1, pa2, pa3;
    SWRITE_HV(0); SBAR();
    if (NT > 1) SLOAD_H(Kh, Vh, KBASE(1));
    SBAR(); qkt<0>(pA0, pA1, K_lds, r32, hi, S.qr, qrl);
    MASKT(pA0, pA1, 0); partialSM(pA0, pA1, m_reg, mnA, alA);
    if (NT > 1) { VMW(); SWRITE_H(1); }
    __syncthreads();
#define HALF_STEP(PX0, PX1, mnX, alX, PY0, PY1, alY, t, KB, VB, SB) do {                                                      \
        SBAR(); qkt<KB>(PX0, PX1, K_lds, r32, hi, S.qr, qrl);                                                                       \
        finishSM(PY0, PY1, alY, l_reg, pa0, pa1, pa2, pa3); SBAR();                                                           \
        if ((t) + 1 < NT) { SLOAD_H(Kh, Vh, KBASE((t) + 1)); SBAR(); }                                                        \
        pv_tile<VB>(o, vb0, pa0, pa1, pa2, pa3); MASKT(PX0, PX1, (t)); partialSM(PX0, PX1, m_reg, mnX, alX);                  \
        __syncthreads();                                                                                                      \
        if ((t) + 1 < NT) { VMW(); SWRITE_H(SB); }                                                                            \
        RESC(alX); __syncthreads(); } while (0)
    for (int t = 1; t + 1 < NT; t += 2) {
        HALF_STEP(pB0, pB1, mnB, alB, pA0, pA1, alA, t, 1, 0, 0);
        HALF_STEP(pA0, pA1, mnA, alA, pB0, pB1, alB, t + 1, 0, 1, 1);
    }
    const bool even = (NT & 1) == 0;
    if (even) { SBAR(); qkt<1>(pB0, pB1, K_lds, r32, hi, S.qr, qrl); SBAR(); }
    SLOAD_H(nxt.K, nxt.V, kbn); SBAR();
#pragma unroll
    for (int d0 = 0; d0 < 8; ++d0) S.qr[d0] = ld8(nxt.Q + qoff + d0 * 16);
    SBAR();
    finishSM(pA0, pA1, alA, l_reg, pa0, pa1, pa2, pa3); SBAR();
    pv_tile<0>(o, vb0, pa0, pa1, pa2, pa3);
    if (even) { MASKT(pB0, pB1, NT - 1); partialSM(pB0, pB1, m_reg, mnB, alB); __syncthreads(); RESC(alB);
        finishSM(pB0, pB1, alB, l_reg, pa0, pa1, pa2, pa3); SBAR(); pv_tile<1>(o, vb0, pa0, pa1, pa2, pa3); }
    SBAR(); SEAM_K0();
    const bf16x8 tq0 = ld8(nxt.Q + qoff + 128), tq1 = ld8(nxt.Q + qoff + 144), tq2 = ld8(nxt.Q + qoff + 160), tq3 = ld8(nxt.Q + qoff + 176);
    SBAR();
    if (hi == 0) li_l[r32] = l_reg; asm volatile("s_waitcnt lgkmcnt(0)" ::: "memory");
    float rli[16];
#pragma unroll
    for (int r = 0; r < 16; ++r) rli[r] = __builtin_amdgcn_rcpf(li_l[crow(r, hi)]);
    bf16* Ow = cur.O + (size_t)(wid * QBLK) * OS;
#pragma unroll
    for (int r = 0; r < 16; ++r) { const int orow = crow(r, hi);
#pragma unroll
        for (int d0 = 0; d0 < 4; ++d0) { const float v = o[d0][r] * rli[r];
            const float vn = __builtin_bit_cast(float, __builtin_amdgcn_ds_swizzle(__builtin_bit_cast(int, v), (1 << 10) | 0x1f));
            if ((r32 & 1) == 0) *(unsigned*)(Ow + (size_t)orow * OS + d0 * 32 + r32) = cvtpk(v, vn); } }
    SBAR();
    *(bf16x8*)(qrl) = tq0; *(bf16x8*)(qrl + 1024) = tq1; *(bf16x8*)(qrl + 2048) = tq2; *(bf16x8*)(qrl + 3072) = tq3;
    __syncthreads();
#undef RESC
#undef KBASE
#undef MASKT
#undef SEAM_K0
#undef HALF_STEP
}
#undef KT
#undef VT
#undef VMW
#undef VMWN
#undef SLOAD_H
#undef SWRITE_HK
#undef SWRITE_HV
#undef SWRITE_H
}

namespace mk {
typedef unsigned short bf16;
typedef float f32x4 __attribute__((ext_vector_type(4)));
typedef float f32x2 __attribute__((ext_vector_type(2)));
typedef unsigned u32x4 __attribute__((ext_vector_type(4)));
typedef unsigned u32x2 __attribute__((ext_vector_type(2)));
constexpr int NB = 16, S = 4096, T = NB * S, D = 1024, FF = 4096, NH = 8, QR = 512, KVR = 256, NL = 4;
constexpr float ALPHA = 1.6817928305074290f;
constexpr float LN_EPS = 1e-5f, RMS_EPS = 1e-6f;
constexpr int NTHREADS = 512, NWAVES = 8;
constexpr int LDS_BYTES = 147456;
constexpr size_t MiB = 1u << 20;
constexpr size_t WS_W1T = 0, WS_W2T = 32 * MiB, WS_PWT = 64 * MiB, WS_QDT = 65 * MiB, WS_QUT = 67 * MiB, WS_AOT = 70 * MiB, WS_KVINT = 74 * MiB, WS_KVUT = 75 * MiB;
constexpr size_t WS_MOD = 76 * MiB, WS_ST = 78 * MiB, WS_RQ = 78 * MiB + 512 * 1024, WS_RKV = 78 * MiB + 768 * 1024, WS_CS = 80 * MiB;
constexpr size_t WS_K = 96 * MiB, WS_V = 288 * MiB, WS_H = 416 * MiB, WS_ACT = 544 * MiB, WS_XB = 544 * MiB, WS_Q = 544 * MiB, WS_CKR = 800 * MiB, WS_CQ = 864 * MiB, WS_END = 928 * MiB;
constexpr int HALF_T = T / 2;

struct Params {
    const float* x; const float* c; const int* pos; const float* ada_w; const float* ada_b; const float* ln_g; const float* ln_b; const float* w1; const float* w2;
    const float* pool_w; const float* pool_scale; const float* q_down; const float* q_norm_g; const float* q_up; const float* attn_out; const float* kv_in; const float* kv_norm_g;
    const float* k_up; const float* v_up; float* out; unsigned char* ws;
};

__device__ __forceinline__ unsigned f2bf(float f) { unsigned u = __builtin_bit_cast(unsigned, f); return (u + 0x7fffu + ((u >> 16) & 1u)) >> 16; }
__device__ __forceinline__ unsigned pk2(float lo, float hi) { return f2bf(lo) | (f2bf(hi) << 16); }
__device__ __forceinline__ float bf2f(unsigned short h) { return __builtin_bit_cast(float, (unsigned)h << 16); }
#define SWZ_XOR(v, o) __builtin_bit_cast(float, __builtin_amdgcn_ds_swizzle(__builtin_bit_cast(int, (v)), ((o) << 10) | 0x1f))
__device__ __forceinline__ float wave_sum(float v) {
    v += SWZ_XOR(v, 1); v += SWZ_XOR(v, 2); v += SWZ_XOR(v, 4); v += SWZ_XOR(v, 8); v += SWZ_XOR(v, 16);
    { auto rr = __builtin_amdgcn_permlane32_swap(__float_as_uint(v), __float_as_uint(v), false, false); v = __uint_as_float(rr[0]) + __uint_as_float(rr[1]); }
    return v;
}

__device__ __forceinline__ int map_row(int map, int n) {
    if (map == 0) return n;
    const int h = n / 192, d = n - h * 192;
    if (d < 128) return h * 128 + d;
    const int rd = d - 128, half = rd >> 5, i = rd & 31;
    return 1024 + h * 64 + (i >> 2) * 8 + half * 4 + (i & 3);
}
__device__ __forceinline__ void transpose_item(const float* W, int K, int N, bf16* WT, int row_off, int map, const float* kscale, float* scr, int item, int lane) {
    const int nblk = N / 32, kb = item / nblk, nb = item % nblk, k0 = 64 * kb, n0 = 32 * nb;
#pragma unroll 8
    for (int i = 0; i < 32; ++i) { const int kk = 2 * i + (lane >> 5); float v = W[(size_t)(k0 + kk) * N + n0 + (lane & 31)]; if (kscale) v *= kscale[k0 + kk]; scr[kk * 33 + (lane & 31)] = v; }
    asm volatile("s_waitcnt lgkmcnt(0)" ::: "memory");
    const int c = lane & 7;
#pragma unroll
    for (int j = 0; j < 4; ++j) { const int n = (lane >> 3) + 8 * j; const float* s = scr + (8 * c) * 33 + n;
        u32x4 o; o.x = pk2(s[0 * 33], s[1 * 33]); o.y = pk2(s[2 * 33], s[3 * 33]); o.z = pk2(s[4 * 33], s[5 * 33]); o.w = pk2(s[6 * 33], s[7 * 33]);
        *(u32x4*)(WT + (size_t)(row_off + map_row(map, n0 + n)) * K + k0 + 8 * c) = o; }
    asm volatile("s_waitcnt lgkmcnt(0)" ::: "memory");
}

__device__ __forceinline__ void p0_mod(const Params& p, unsigned char* lds, int tid, int wave, int lane, int bid, int G) {
    float* sc = (float*)lds;
    float* red = sc + 16384;
    float* mod = (float*)(p.ws + WS_MOD);
    for (int i = tid; i < 16384; i += NTHREADS) { const float v = p.c[i]; sc[i] = v / (1.f + __expf(-v)); }
    __syncthreads();
    for (int item = bid; item < 384; item += G) {
        const int gc = item * 64 + lane, l = gc / 6144, m = gc - l * 6144;
        const float* wp = p.ada_w + ((size_t)l * 1024 + wave * 128) * 6144 + m;
        const float* sp = sc + wave * 128;
        float acc[16];
#pragma unroll
        for (int b = 0; b < 16; ++b) acc[b] = 0.f;
#pragma unroll 4
        for (int k = 0; k < 128; ++k) { const float w = wp[(size_t)k * 6144];
#pragma unroll
            for (int b = 0; b < 16; ++b) acc[b] = fmaf(w, sp[b * 1024 + k], acc[b]); }
#pragma unroll
        for (int b = 0; b < 16; ++b) red[(wave * 16 + b) * 64 + lane] = acc[b];
        __syncthreads();
        for (int o = tid; o < 1024; o += NTHREADS) { const int b = o >> 6, ci = o & 63; float s = 0.f;
#pragma unroll
            for (int w = 0; w < 8; ++w) s += red[(w * 16 + b) * 64 + ci];
            const int gcc = item * 64 + ci; mod[(size_t)b * 24576 + gcc] = s + p.ada_b[gcc]; }
        __syncthreads();
    }
}

__device__ __forceinline__ void p0_cs(const Params& p, int gtid, int nthr) {
    float* cs = (float*)(p.ws + WS_CS);
    for (int idx = gtid; idx < T * 32; idx += nthr) {
        const int t = idx >> 5, i = idx & 31;
        double inv = 1.0; for (int j = 0; j < i; ++j) inv *= 0.74989420933245582730;
        const double ang = (double)p.pos[t] * inv;
        const double k = __builtin_rint(ang * 0.63661977236758134308);
        double y = __builtin_fma(-k, 1.57079632673412561417e+00, ang); y = __builtin_fma(-k, 6.07710050650619224932e-11, y);
        const double y2 = y * y;
        double sn = -1.0 / 6227020800.0; sn = sn * y2 + 1.0 / 39916800.0; sn = sn * y2 - 1.0 / 362880.0; sn = sn * y2 + 1.0 / 5040.0; sn = sn * y2 - 1.0 / 120.0; sn = sn * y2 + 1.0 / 6.0; sn = y - y * y2 * sn;
        double cn = 1.0 / 87178291200.0; cn = cn * y2 - 1.0 / 479001600.0; cn = cn * y2 + 1.0 / 3628800.0; cn = cn * y2 - 1.0 / 40320.0; cn = cn * y2 + 1.0 / 720.0; cn = cn * y2 - 1.0 / 24.0; cn = cn * y2 + 0.5; cn = 1.0 - y2 * cn;
        const int q = (int)((long long)k & 3);
        const double cc = (q == 0) ? cn : (q == 1) ? -sn : (q == 2) ? -cn : sn;
        const double ss = (q == 0) ? sn : (q == 1) ? cn : (q == 2) ? -sn : -cn;
        *(f32x2*)(cs + (size_t)idx * 2) = (f32x2){(float)cc, (float)ss};
    }
}

__device__ __forceinline__ void p0_weights(const Params& p, unsigned char* lds, int gw, int NGW, int wave, int lane) {
    float* scr = (float*)(lds + wave * 16384);
    bf16* W1T = (bf16*)(p.ws + WS_W1T); bf16* W2T = (bf16*)(p.ws + WS_W2T); bf16* PWT = (bf16*)(p.ws + WS_PWT); bf16* QDT = (bf16*)(p.ws + WS_QDT);
    bf16* QUT = (bf16*)(p.ws + WS_QUT); bf16* AOT = (bf16*)(p.ws + WS_AOT); bf16* KVINT = (bf16*)(p.ws + WS_KVINT); bf16* KVUT = (bf16*)(p.ws + WS_KVUT);
    constexpr int I_W1 = (D / 64) * (FF / 32), I_W2 = (FF / 64) * (D / 32), I_PW = 4 * 8, I_QD = 16 * 16, I_QU = 8 * 48, I_AO = 16 * 32, I_KVIN = 16 * 10, I_KU = 4 * 32;
    constexpr int NITEMS = 4 * I_W1 + 4 * I_W2 + 8 * I_PW + 2 * I_QD + 2 * I_QU + 2 * I_AO + I_KVIN + 2 * I_KU;
    for (int it = gw; it < NITEMS; it += NGW) {
        int r = it;
        if (r < 4 * I_W1) { const int l = r / I_W1; transpose_item(p.w1 + (size_t)l * D * FF, D, FF, W1T + (size_t)l * D * FF, 0, 0, nullptr, scr, r % I_W1, lane); continue; } r -= 4 * I_W1;
        if (r < 4 * I_W2) { const int l = r / I_W2; transpose_item(p.w2 + (size_t)l * D * FF, FF, D, W2T + (size_t)l * D * FF, 0, 0, nullptr, scr, r % I_W2, lane); continue; } r -= 4 * I_W2;
        if (r < 8 * I_PW) { const int g = r / I_PW; transpose_item(p.pool_w + (size_t)g * 65536, 256, 256, PWT + (size_t)g * 65536, 0, 0, nullptr, scr, r % I_PW, lane); continue; } r -= 8 * I_PW;
        if (r < 2 * I_QD) { const int j = r / I_QD; transpose_item(p.q_down + (size_t)j * D * QR, D, QR, QDT + (size_t)j * D * QR, 0, 0, nullptr, scr, r % I_QD, lane); continue; } r -= 2 * I_QD;
        if (r < 2 * I_QU) { const int j = r / I_QU; transpose_item(p.q_up + (size_t)j * QR * 1536, QR, 1536, QUT + (size_t)j * QR * 1536, 0, 1, p.q_norm_g + j * QR, scr, r % I_QU, lane); continue; } r -= 2 * I_QU;
        if (r < 2 * I_AO) { const int j = r / I_AO; transpose_item(p.attn_out + (size_t)j * D * D, D, D, AOT + (size_t)j * D * D, 0, 0, nullptr, scr, r % I_AO, lane); continue; } r -= 2 * I_AO;
        if (r < I_KVIN) { transpose_item(p.kv_in, D, 320, KVINT, 0, 0, nullptr, scr, r, lane); continue; } r -= I_KVIN;
        if (r < I_KU) { transpose_item(p.k_up, KVR, 1024, KVUT, 0, 0, p.kv_norm_g, scr, r, lane); continue; } r -= I_KU;
        transpose_item(p.v_up, KVR, 1024, KVUT, 1024, 0, p.kv_norm_g, scr, r, lane);
    }
    { u32x4* z = (u32x4*)(KVINT + (size_t)320 * D); const int nz = 192 * D / 8;
      for (int i = gw * 64 + lane; i < nz; i += NGW * 64) z[i] = (u32x4){0u, 0u, 0u, 0u}; }
}

__device__ __forceinline__ void prep_rows(const float* z, const float* lng, const float* lnb, const float* modl  , int shi, float* st, bf16* H, bf16* XB, int gw, int NGW, int lane) {
    for (int m = gw; m < T; m += NGW) {
        const int b = m >> 12;
        const f32x4* xr = (const f32x4*)(z + (size_t)m * D) + lane;
        f32x4 v[4]; float s = 0.f;
#pragma unroll
        for (int j = 0; j < 4; ++j) { v[j] = xr[64 * j]; s += (v[j].x + v[j].y) + (v[j].z + v[j].w); }
        const float mean = wave_sum(s) * (1.f / D); float s2 = 0.f;
#pragma unroll
        for (int j = 0; j < 4; ++j) { v[j] = v[j] - mean; s2 += (v[j].x * v[j].x + v[j].y * v[j].y) + (v[j].z * v[j].z + v[j].w * v[j].w); }
        const float rstd = 1.f / sqrtf(wave_sum(s2) * (1.f / D) + LN_EPS);
        if (lane == 0) *(f32x2*)(st + (size_t)m * 2) = (f32x2){mean, rstd};
        const float* shp = modl + (size_t)b * 24576 + shi * 1024; const float* scp = shp + 1024;
        unsigned long long* h8 = (unsigned long long*)(H + (size_t)m * D) + lane;
        unsigned long long* x8 = XB ? (unsigned long long*)(XB + (size_t)m * D) + lane : nullptr;
#pragma unroll
        for (int j = 0; j < 4; ++j) { const int c = 4 * lane + 256 * j;
            const f32x4 g = *(const f32x4*)(lng + c), bb = *(const f32x4*)(lnb + c), sh = *(const f32x4*)(shp + c), sc = *(const f32x4*)(scp + c);
            const f32x4 x = v[j] * rstd * g + bb;
            if (XB) x8[64 * j] = (unsigned long long)pk2(x.x, x.y) | ((unsigned long long)pk2(x.z, x.w) << 32);
            const f32x4 h = x * (sc + 1.f) + sh;
            h8[64 * j] = (unsigned long long)pk2(h.x, h.y) | ((unsigned long long)pk2(h.z, h.w) << 32); }
    }
}
__device__ __forceinline__ void final_ln(const float* z, const float* lng, const float* lnb, float* out, int gw, int NGW, int lane) {
    for (int m = gw; m < T; m += NGW) {
        const f32x4* xr = (const f32x4*)(z + (size_t)m * D) + lane;
        f32x4 v[4]; float s = 0.f;
#pragma unroll
        for (int j = 0; j < 4; ++j) { v[j] = xr[64 * j]; s += (v[j].x + v[j].y) + (v[j].z + v[j].w); }
        const float mean = wave_sum(s) * (1.f / D); float s2 = 0.f;
#pragma unroll
        for (int j = 0; j < 4; ++j) { v[j] = v[j] - mean; s2 += (v[j].x * v[j].x + v[j].y * v[j].y) + (v[j].z * v[j].z + v[j].w * v[j].w); }
        const float rstd = 1.f / sqrtf(wave_sum(s2) * (1.f / D) + LN_EPS);
        f32x4* o = (f32x4*)(out + (size_t)m * D) + lane;
#pragma unroll
        for (int j = 0; j < 4; ++j) { const int c = 4 * lane + 256 * j; o[64 * j] = v[j] * rstd * *(const f32x4*)(lng + c) + *(const f32x4*)(lnb + c); }
    }
}
__device__ __forceinline__ void rms_rows_q(const bf16* CQ, float* rq, int gw, int NGW, int lane) {
    for (int m = gw; m < T; m += NGW) {
        const u32x4 w = *((const u32x4*)(CQ + (size_t)m * QR) + lane); float ss = 0.f;
#pragma unroll
        for (int e = 0; e < 4; ++e) { const float a = __builtin_bit_cast(float, w[e] << 16), b = __builtin_bit_cast(float, w[e] & 0xffff0000u); ss += a * a + b * b; }
        ss = wave_sum(ss);
        if (lane == 0) rq[m] = 1.f / sqrtf(ss * (1.f / QR) + RMS_EPS);
    }
}
__device__ __forceinline__ void kv_rows(const bf16* CKR, const float* cs, float* rkv, bf16* Kf, int gw, int NGW, int lane) {
    for (int m = gw; m < T; m += NGW) {
        const bf16* row = CKR + (size_t)m * 512;
        const u32x2 w = *((const u32x2*)row + lane); float ss = 0.f;
#pragma unroll
        for (int e = 0; e < 2; ++e) { const float a = __builtin_bit_cast(float, w[e] << 16), b = __builtin_bit_cast(float, w[e] & 0xffff0000u); ss += a * a + b * b; }
        ss = wave_sum(ss);
        if (lane == 0) rkv[m] = 1.f / sqrtf(ss * (1.f / KVR) + RMS_EPS);
        if (lane < 32) { const float k1 = bf2f(row[256 + lane]), k2 = bf2f(row[288 + lane]); const f32x2 c = *(const f32x2*)(cs + ((size_t)m * 32 + lane) * 2);
            const bf16 o1 = (bf16)f2bf(k1 * c.x - k2 * c.y), o2 = (bf16)f2bf(k2 * c.x + k1 * c.y);
            bf16* kd = Kf + (size_t)m * 1536 + 128 + lane;
#pragma unroll
            for (int h = 0; h < 8; ++h) { kd[h * 192] = o1; kd[h * 192 + 32] = o2; } }
    }
}

__device__ __forceinline__ void pool_prep(const float* z, bool raw, const float* lng, const float* lnb, const float* modl, float* st, bf16* P, unsigned char* lds, int tid, int wave, int lane, int bid, int G) {
    f32x2* sst = (f32x2*)lds;
    for (int chunk = bid; chunk < T / 64; chunk += G) {
        const int r0 = chunk * 64, seq0 = r0 & ~(S - 1), b = r0 >> 12;
        const int lo = (r0 - 15 > seq0) ? r0 - 15 : seq0;
        if (!raw) {
            for (int rr = lo + wave; rr < r0 + 64; rr += NWAVES) {
                const f32x4* xr = (const f32x4*)(z + (size_t)rr * D) + lane;
                f32x4 v[4]; float s = 0.f;
#pragma unroll
                for (int j = 0; j < 4; ++j) { v[j] = xr[64 * j]; s += (v[j].x + v[j].y) + (v[j].z + v[j].w); }
                const float mean = wave_sum(s) * (1.f / D); float s2 = 0.f;
#pragma unroll
                for (int j = 0; j < 4; ++j) { v[j] = v[j] - mean; s2 += (v[j].x * v[j].x + v[j].y * v[j].y) + (v[j].z * v[j].z + v[j].w * v[j].w); }
                const float rstd = 1.f / sqrtf(wave_sum(s2) * (1.f / D) + LN_EPS);
                if (lane == 0) { sst[rr - (r0 - 15)] = (f32x2){mean, rstd}; if (rr >= r0) *(f32x2*)(st + (size_t)rr * 2) = (f32x2){mean, rstd}; }
            }
        }
        __syncthreads();
        {
            const int cq = tid & 255, rh = tid >> 8, col = 4 * cq, w = 2 << (cq >> 6), t0 = r0 + rh * 32;
            f32x4 lg = (f32x4){1.f, 1.f, 1.f, 1.f}, lb = (f32x4){0.f, 0.f, 0.f, 0.f};
            if (!raw) { lg = *(const f32x4*)(lng + col); lb = *(const f32x4*)(lnb + col); }
            const f32x4 sh = *(const f32x4*)(modl + (size_t)b * 24576 + col), sc1 = *(const f32x4*)(modl + (size_t)b * 24576 + 1024 + col) + 1.f;
            const int us = (t0 - (w - 1) > seq0) ? t0 - (w - 1) : seq0;
            f32x4 Sx = (f32x4){0.f, 0.f, 0.f, 0.f};
#define HVAL(t_, dst) do { f32x4 zz = *(const f32x4*)(z + (size_t)(t_) * D + col); if (!raw) { const f32x2 s_ = sst[(t_) - (r0 - 15)]; zz = (zz - s_.x) * s_.y * lg + lb; } dst = zz * sc1 + sh; } while (0)
            for (int t = us; t < t0 + 32; ++t) {
                f32x4 hv; HVAL(t, hv); Sx = Sx + hv;
                if (t - w >= us) { f32x4 ho; HVAL(t - w, ho); Sx = Sx - ho; }
                if (t >= t0) { const int n = t - seq0 + 1; const float ic = 1.f / (float)(n < w ? n : w);
                    const f32x4 o = Sx * ic - hv;
                    *(u32x2*)(P + (size_t)t * D + col) = (u32x2){pk2(o.x, o.y), pk2(o.z, o.w)}; }
            }
#undef HVAL
        }
        __syncthreads();
    }
}

__device__ __forceinline__ att::BlockRef att_ref(int L, int pass, const bf16* Q, const bf16* K, const bf16* V, bf16* O) {
    const int bh = L >> 3, x = L & 7, b = bh >> 3, h = bh & 7, qb = pass ? 15 - x : x;
    att::BlockRef r;
    r.Q = Q + ((size_t)b * S + (size_t)qb * 256) * 1536 + h * 192; r.O = O + ((size_t)b * S + (size_t)qb * 256) * 1024 + h * 128;
    r.K = K + (size_t)b * S * 1536 + h * 192; r.V = V + (size_t)b * S * 1024 + h * 128; r.P0 = qb * 256;
    return r;
}
__device__ __forceinline__ void attn_phase(const bf16* Q, const bf16* K, const bf16* V, bf16* O, char* lds, int bid, int G) {
    const int total = NB * NH * 8, stride = G;
    int L = bid; if (L >= total) return;
    int pass = 0;
    att::BlockRef cur = att_ref(L, 0, Q, K, V, O);
    att::Seam Sm;
    att::causal_prime(cur, lds, Sm);
    for (;;) {
        const bool more_pass = pass == 0, more_item = L + stride < total, last = !more_pass && !more_item;
        int passn = pass + 1, Ln = L;
        if (!more_pass) { passn = 0; Ln = more_item ? L + stride : L; }
        const att::BlockRef nxt = last ? cur : att_ref(Ln, passn, Q, K, V, O);
        att::causal_block(cur, nxt, lds, Sm);
        if (last) break;
        cur = nxt; pass = passn; L = Ln;
    }
}

__global__ void __launch_bounds__(NTHREADS, 2) yoco_fwd(Params p_unused) {
    extern __shared__ __attribute__((aligned(16))) unsigned char lds[];
    cg::grid_group grid = cg::this_grid();
#define PH() const __attribute__((address_space(4))) Params* pp_ = (const __attribute__((address_space(4))) Params*)__builtin_amdgcn_kernarg_segment_ptr(); asm volatile("" : "+s"(pp_)); \
             int tid = threadIdx.x; asm volatile("" : "+v"(tid)); int bid = blockIdx.x; asm volatile("" : "+s"(bid)); int G = gridDim.x; asm volatile("" : "+s"(G)); const int lane = tid & 63, wave = __builtin_amdgcn_readfirstlane(tid >> 6), gw = bid * NWAVES + wave, NGW = G * NWAVES; \
             unsigned char* const ws = pp_->ws; float* const Z = pp_->out; (void)lane; (void)gw; (void)NGW; (void)ws; (void)Z; (void)tid
#define WSP(type, off) ((type*)(ws + (off)))
#define LDSL ((PG8_LAS unsigned char*)lds)
#define MODL (WSP(float, WS_MOD) + (size_t)l * 6144)
#define LNG_PREV (pp_->ln_g + (size_t)(l * 2 - 1) * D)
#define LNB_PREV (pp_->ln_b + (size_t)(l * 2 - 1) * D)
#define LNG0 (pp_->ln_g + (size_t)(l * 2) * D)
#define LNB0 (pp_->ln_b + (size_t)(l * 2) * D)

    { PH(); const Params& p = p_unused;
      p0_mod(p, lds, tid, wave, lane, bid, G);
      p0_cs(p, bid * NTHREADS + tid, G * NTHREADS);
      p0_weights(p, lds, gw, NGW, wave, lane); }
    grid.sync();

    for (int l = 0; l < NL; ++l) {
        if (l < 2) {
            { PH(); const bool raw = (l == 0);
              pool_prep(raw ? pp_->x : Z, raw, LNG_PREV, LNB_PREV, MODL, WSP(float, WS_ST), WSP(bf16, WS_H), lds, tid, wave, lane, bid, G); }
            grid.sync();
            { PH(); const bool raw = (l == 0);
              pg8::Gemm g{WSP(bf16, WS_H), WSP(bf16, WS_PWT) + (size_t)l * 4 * 65536, T, D, 256, D, (size_t)512};
              pg8::StaticOrder So; So.init(T, D, G, bid);
              pg8::EpiRes E{raw ? pp_->x : Z, Z, raw ? nullptr : WSP(float, WS_ST), LNG_PREV, LNB_PREV, MODL + 2 * 1024, pp_->pool_scale + (size_t)l * D, 0, ALPHA};
              pg8::gemm_phase<pg8::EpiRes, pg8::StaticOrder, true, true>(LDSL, g, So, E); }
            grid.sync();
        } else {
            const int j = l - 2;
            { PH(); prep_rows(Z, LNG_PREV, LNB_PREV, MODL, 0, WSP(float, WS_ST), WSP(bf16, WS_H), (j == 0) ? WSP(bf16, WS_XB) : nullptr, gw, NGW, lane); }
            grid.sync();
            if (j == 0) { PH();
              pg8::Gemm g{WSP(bf16, WS_XB), WSP(bf16, WS_KVINT), T, 512, D, D, (size_t)0};
              pg8::StaticOrder So; So.init(T, 512, G, bid);
              pg8::EpiBf16<0> E{WSP(bf16, WS_CKR), 512};
              pg8::gemm_phase<pg8::EpiBf16<0>, pg8::StaticOrder, true, true>(LDSL, g, So, E); }
            { PH();
              pg8::Gemm g{WSP(bf16, WS_H), WSP(bf16, WS_QDT) + (size_t)j * D * QR, T, QR, D, D, (size_t)0};
              pg8::StaticOrder So; So.init(T, QR, G, bid);
              pg8::EpiBf16<0> E{WSP(bf16, WS_CQ), QR};
              pg8::gemm_phase<pg8::EpiBf16<0>, pg8::StaticOrder, true, true>(LDSL, g, So, E); }
            grid.sync();
            { PH(); if (j == 0) kv_rows(WSP(bf16, WS_CKR), WSP(float, WS_CS), WSP(float, WS_RKV), WSP(bf16, WS_K), gw, NGW, lane);
              rms_rows_q(WSP(bf16, WS_CQ), WSP(float, WS_RQ), gw, NGW, lane); }
            grid.sync();
            if (j == 0) { PH();
              pg8::Gemm g{WSP(bf16, WS_CKR), WSP(bf16, WS_KVUT), T, 2048, KVR, 512, (size_t)0};
              pg8::StaticOrder So; So.init(T, 2048, G, bid);
              pg8::EpiHead<0> E{WSP(bf16, WS_K), WSP(bf16, WS_V), WSP(float, WS_RKV), WSP(float, WS_CS)};
              pg8::gemm_phase<pg8::EpiHead<0>, pg8::StaticOrder, true, true>(LDSL, g, So, E); }
            { PH();
              pg8::Gemm g{WSP(bf16, WS_CQ), WSP(bf16, WS_QUT) + (size_t)j * QR * 1536, T, 1536, QR, QR, (size_t)0};
              pg8::StaticOrder So; So.init(T, 1536, G, bid);
              pg8::EpiHead<1> E{WSP(bf16, WS_Q), nullptr, WSP(float, WS_RQ), WSP(float, WS_CS)};
              pg8::gemm_phase<pg8::EpiHead<1>, pg8::StaticOrder, true, true>(LDSL, g, So, E); }
            grid.sync();
#ifndef NO_ATT
            { PH(); attn_phase(WSP(bf16, WS_Q), WSP(bf16, WS_K), WSP(bf16, WS_V), WSP(bf16, WS_H), (char*)lds, bid, G); }
#endif
            grid.sync();
            { PH();
              pg8::Gemm g{WSP(bf16, WS_H), WSP(bf16, WS_AOT) + (size_t)j * D * D, T, D, D, D, (size_t)0};
              pg8::StaticOrder So; So.init(T, D, G, bid);
              pg8::EpiRes E{Z, Z, WSP(float, WS_ST), LNG_PREV, LNB_PREV, MODL + 2 * 1024, nullptr, 0, ALPHA};
              pg8::gemm_phase<pg8::EpiRes, pg8::StaticOrder, true, true>(LDSL, g, So, E); }
            grid.sync();
        }
        { PH(); prep_rows(Z, LNG0, LNB0, MODL, 3, WSP(float, WS_ST), WSP(bf16, WS_H), nullptr, gw, NGW, lane); }
        grid.sync();
        for (int half = 0; half < 2; ++half) {
            { PH();
              pg8::Gemm g{WSP(bf16, WS_H) + (size_t)half * HALF_T * D, WSP(bf16, WS_W1T) + (size_t)l * D * FF, HALF_T, FF, D, D, (size_t)0};
              pg8::StaticOrder So; So.init(HALF_T, FF, G, bid);
              pg8::EpiBf16<1> E{WSP(bf16, WS_ACT), FF};
              pg8::gemm_phase<pg8::EpiBf16<1>, pg8::StaticOrder, true, true>(LDSL, g, So, E); }
            grid.sync();
            { PH();
              pg8::Gemm g{WSP(bf16, WS_ACT), WSP(bf16, WS_W2T) + (size_t)l * D * FF, HALF_T, D, FF, FF, (size_t)0};
              pg8::StaticOrder So; So.init(HALF_T, D, G, bid);
              pg8::EpiRes E{Z, Z, WSP(float, WS_ST), LNG0, LNB0, MODL + 5 * 1024, nullptr, half * HALF_T, ALPHA};
              pg8::gemm_phase<pg8::EpiRes, pg8::StaticOrder, true, true>(LDSL, g, So, E); }
            grid.sync();
        }
    }
    { PH(); final_ln(Z, pp_->ln_g + (size_t)7 * D, pp_->ln_b + (size_t)7 * D, Z, gw, NGW, lane); }
}
}

extern "C" void kernel_launch(void* const* d_in, const int* in_sizes, int n_in, void* d_out, int out_size, void* d_ws, size_t ws_size, hipStream_t stream) {
    using namespace mk;
    static int grid = 0;
    if (grid == 0) {
        if (n_in != 19 || in_sizes[0] != T * D || out_size != T * D || ws_size < WS_END) { fprintf(stderr, "kernel_launch: unexpected shapes (n_in %d, in0 %d, out %d, ws %zu)\n", n_in, n_in > 0 ? in_sizes[0] : -1, out_size, ws_size); grid = -1; return; }
        int dev = 0, cus = 0, per_cu = 0;
        (void)hipGetDevice(&dev); (void)hipDeviceGetAttribute(&cus, hipDeviceAttributeMultiprocessorCount, dev);
        if (hipFuncSetAttribute((const void*)yoco_fwd, hipFuncAttributeMaxDynamicSharedMemorySize, LDS_BYTES) != hipSuccess) { fprintf(stderr, "kernel_launch: hipFuncSetAttribute failed\n"); grid = -1; return; }
        if (hipOccupancyMaxActiveBlocksPerMultiprocessor(&per_cu, (const void*)yoco_fwd, NTHREADS, LDS_BYTES) != hipSuccess || per_cu < 1) { fprintf(stderr, "kernel_launch: occupancy query gave %d\n", per_cu); per_cu = 1; }
        (void)hipGetLastError();
        grid = cus * per_cu;
    }
    if (grid < 0) return;
    Params p{};
    p.x = (const float*)d_in[0]; p.c = (const float*)d_in[1]; p.pos = (const int*)d_in[2]; p.ada_w = (const float*)d_in[3]; p.ada_b = (const float*)d_in[4];
    p.ln_g = (const float*)d_in[5]; p.ln_b = (const float*)d_in[6]; p.w1 = (const float*)d_in[7]; p.w2 = (const float*)d_in[8]; p.pool_w = (const float*)d_in[9];
    p.pool_scale = (const float*)d_in[10]; p.q_down = (const float*)d_in[11]; p.q_norm_g = (const float*)d_in[12]; p.q_up = (const float*)d_in[13]; p.attn_out = (const float*)d_in[14];
    p.kv_in = (const float*)d_in[15]; p.kv_norm_g = (const float*)d_in[16]; p.k_up = (const float*)d_in[17]; p.v_up = (const float*)d_in[18];
    p.out = (float*)d_out; p.ws = (unsigned char*)d_ws;
    void* args[] = {&p};
    const hipError_t e = hipLaunchCooperativeKernel((const void*)yoco_fwd, dim3(grid), dim3(NTHREADS), args, LDS_BYTES, stream);
    if (e != hipSuccess) fprintf(stderr, "kernel_launch: cooperative launch failed: %s (grid %d)\n", hipGetErrorString(e), grid);
}
```

```cpp
#include <hip/hip_runtime.h>
#include <hip/hip_cooperative_groups.h>
#include <cstdio>
#include <cstdint>
namespace cg = cooperative_groups;
#ifndef DUP_G1
#define DUP_G1 0
#endif
#ifndef DUP_ATT
#define DUP_ATT 0
#endif
#ifndef DUP_ROWS
#define DUP_ROWS 0
#endif
#ifndef DUP_SYNC
#define DUP_SYNC 0
#endif
#ifndef DUP_G2
#define DUP_G2 0
#endif

namespace pg8 {
#define PG8_LAS __attribute__((address_space(3)))
typedef unsigned short bf16_t;
typedef short bf16x8 __attribute__((ext_vector_type(8)));
typedef float f32x4 __attribute__((ext_vector_type(4)));
typedef float f32x2 __attribute__((ext_vector_type(2)));
typedef unsigned u32x4 __attribute__((ext_vector_type(4)));
typedef unsigned u32x2 __attribute__((ext_vector_type(2)));
constexpr int BM = 256, BK = 64, HALF = 128, HTB = HALF * BK * 2  , STAGE_BYTES = 8 * HTB, NXCD = 8, WGM = 8;

__host__ __device__ __forceinline__ int lds_byte(int r, int c) { const int st = (r >> 4) * 2 + (c >> 5), rr = r & 15, cc = c & 31, ob = rr * 64 + cc * 2; return st * 1024 + (ob ^ (((ob >> 9) & 1) << 5)); }
__host__ __device__ __forceinline__ void stage_rc(int b, int& R, int& C) { const int st = b / 1024, sb = b % 1024, swz = sb ^ (((sb >> 9) & 1) << 5); R = (st >> 1) * 16 + swz / 64; C = (st & 1) * 32 + (swz % 64) / 2; }
__host__ __device__ __forceinline__ int perm32(int rho) { const int n = rho >> 4, i = rho & 15; return 8 * (i >> 2) + 4 * n + (i & 3); }

struct Unit { int pm, pn; };
struct Gemm { const bf16_t* A; const bf16_t* Bt; int M, N, K, lda; size_t a_pn_off; };

struct StaticOrder {
    int nM, nN, nwg, G, c;
    __host__ __device__ void init(int M, int N, int G_, int c_) { nM = M / BM; nN = N / BM; nwg = nM * nN; G = G_; c = c_; }
    __host__ __device__ bool next(int i, Unit& u) const {
        const long L = (long)i * G + c; if (L >= nwg) return false;
        int wgid = (int)L; { const int q = nwg / NXCD, r = nwg % NXCD, xcd = wgid % NXCD, off = wgid / NXCD; wgid = (xcd < r ? xcd * (q + 1) : r * (q + 1) + (xcd - r) * q) + off; }
        const int nig = WGM * nN, gid = wgid / nig, fm = gid * WGM, gsz = (nM - fm) < WGM ? (nM - fm) : WGM;
        u.pm = fm + ((wgid % nig) % gsz); u.pn = (wgid % nig) / gsz; return true;
    }
    __device__ __forceinline__ void a_ready(const Unit&) const {}
    __device__ __forceinline__ void done(const Unit&) const {}
};

#define EPI_IDS() int t_ = threadIdx.x; asm volatile("" : "+v"(t_)); const int w_ = __builtin_amdgcn_readfirstlane(t_ >> 6), wr = w_ >> 2, wc = w_ & 3, fr = t_ & 15, fq = (t_ & 63) >> 4; (void)wr_; (void)wc_; (void)fr_; (void)fq_
__device__ __forceinline__ unsigned cvt_pk_bf16(float lo, float hi) { unsigned r; asm volatile("v_cvt_pk_bf16_f32 %0, %1, %2" : "=v"(r) : "v"(lo), "v"(hi)); return r; }

template <int ACT> struct EpiBf16 {
    static constexpr bool PERM = true, AFTER_DRAIN = false;
    bf16_t* O; int ldc;
    __device__ __forceinline__ void operator()(const f32x4 (&acc)[2][2][4][2], const Unit& u, int wr_, int wc_, int fr_, int fq_) const {
        EPI_IDS();
        const int row0 = u.pm * BM + wr * 64 + fr; const int col0 = u.pn * BM + wc * 32 + 8 * fq;
#pragma unroll
        for (int ai = 0; ai < 2; ++ai)
#pragma unroll
            for (int m = 0; m < 4; ++m) { bf16_t* rowp = O + (size_t)(row0 + ai * HALF + m * 16) * ldc + col0;
#pragma unroll
                for (int bj = 0; bj < 2; ++bj) { f32x4 v0 = acc[ai][bj][m][0], v1 = acc[ai][bj][m][1];
                    if (ACT == 1) {
#pragma unroll
                        for (int e = 0; e < 4; ++e) { const float a = fmaxf(v0[e], 0.f), b = fmaxf(v1[e], 0.f); v0[e] = a * a; v1[e] = b * b; } }
                    u32x4 w; w.x = cvt_pk_bf16(v0[0], v0[1]); w.y = cvt_pk_bf16(v0[2], v0[3]); w.z = cvt_pk_bf16(v1[0], v1[1]); w.w = cvt_pk_bf16(v1[2], v1[3]);
                    *(u32x4*)(rowp + bj * HALF) = w; } }
    }
};

template <int MODE2> struct EpiHead {
    static constexpr bool PERM = true, AFTER_DRAIN = false;
    bf16_t* O1; bf16_t* O2; const float* rscale; const float* cs;
    __device__ __forceinline__ void operator()(const f32x4 (&acc)[2][2][4][2], const Unit& u, int wr_, int wc_, int fr_, int fq_) const {
        EPI_IDS();
        const int row0 = u.pm * BM + wr * 64 + fr;
#pragma unroll
        for (int ai = 0; ai < 2; ++ai)
#pragma unroll
            for (int m = 0; m < 4; ++m) { const int row = row0 + ai * HALF + m * 16; const float rs = rscale[row];
#pragma unroll
                for (int bj = 0; bj < 2; ++bj) { const f32x4 v0 = acc[ai][bj][m][0] * rs, v1 = acc[ai][bj][m][1] * rs;
                    if (u.pn < 4) {
                        u32x4 w; w.x = cvt_pk_bf16(v0[0], v0[1]); w.y = cvt_pk_bf16(v0[2], v0[3]); w.z = cvt_pk_bf16(v1[0], v1[1]); w.w = cvt_pk_bf16(v1[2], v1[3]);
                        *(u32x4*)(O1 + (size_t)row * 1536 + (u.pn * 2 + bj) * 192 + wc * 32 + 8 * fq) = w;
                    } else if (MODE2 == 0) {
                        u32x4 w; w.x = cvt_pk_bf16(v0[0], v0[1]); w.y = cvt_pk_bf16(v0[2], v0[3]); w.z = cvt_pk_bf16(v1[0], v1[1]); w.w = cvt_pk_bf16(v1[2], v1[3]);
                        *(u32x4*)(O2 + (size_t)row * 1024 + (u.pn - 4) * BM + bj * HALF + wc * 32 + 8 * fq) = w;
                    } else {
                        const int head = (u.pn - 4) * 4 + bj * 2 + (wc >> 1), i0 = ((wc & 1) * 4 + fq) * 4;
                        const f32x4 c0 = *(const f32x4*)(cs + ((size_t)row * 32 + i0) * 2), c1 = *(const f32x4*)(cs + ((size_t)row * 32 + i0) * 2 + 4);
                        const float o10 = v0[0] * c0[0] - v1[0] * c0[1], o20 = v1[0] * c0[0] + v0[0] * c0[1];
                        const float o11 = v0[1] * c0[2] - v1[1] * c0[3], o21 = v1[1] * c0[2] + v0[1] * c0[3];
                        const float o12 = v0[2] * c1[0] - v1[2] * c1[1], o22 = v1[2] * c1[0] + v0[2] * c1[1];
                        const float o13 = v0[3] * c1[2] - v1[3] * c1[3], o23 = v1[3] * c1[2] + v0[3] * c1[3];
                        bf16_t* dst = O1 + (size_t)row * 1536 + head * 192 + 128 + i0;
                        u32x2 w1, w2; w1.x = cvt_pk_bf16(o10, o11); w1.y = cvt_pk_bf16(o12, o13); w2.x = cvt_pk_bf16(o20, o21); w2.y = cvt_pk_bf16(o22, o23);
                        *(u32x2*)dst = w1; *(u32x2*)(dst + 32) = w2;
                    } } }
    }
};

struct EpiRes {
    static constexpr bool PERM = false, AFTER_DRAIN = false;
    const float* zin; float* zout; const float* stats; const float* lng; const float* lnb; const float* gate  ; const float* gmul; int row_base; float alpha;
    __device__ __forceinline__ void operator()(const f32x4 (&acc)[2][2][4][2], const Unit& u, int wr_, int wc_, int fr_, int fq_) const {
        EPI_IDS();
        const int col0 = u.pn * BM + wc * 32 + 4 * fq; const int rt0 = row_base + u.pm * BM; const int b = rt0 >> 12;
        f32x4 gv[2][2], lg[2][2], lb[2][2];
#pragma unroll
        for (int bj = 0; bj < 2; ++bj)
#pragma unroll
            for (int n = 0; n < 2; ++n) { const int c = col0 + bj * HALF + n * 16; f32x4 g = *(const f32x4*)(gate + (size_t)b * 24576 + c);
                if (gmul) g = g * *(const f32x4*)(gmul + c); gv[bj][n] = g;
                if (stats) { lg[bj][n] = *(const f32x4*)(lng + c); lb[bj][n] = *(const f32x4*)(lnb + c); } else { lg[bj][n] = (f32x4){1.f, 1.f, 1.f, 1.f}; lb[bj][n] = (f32x4){0.f, 0.f, 0.f, 0.f}; } }
#pragma unroll
        for (int ai = 0; ai < 2; ++ai)
#pragma unroll
            for (int m = 0; m < 4; ++m) { const int r = rt0 + ai * HALF + wr * 64 + m * 16 + fr; float mu = 0.f, rstd = 1.f;
                if (stats) { const f32x2 s = *(const f32x2*)(stats + (size_t)r * 2); mu = s.x; rstd = s.y; }
                const size_t off = (size_t)r * 1024 + col0;
#pragma unroll
                for (int bj = 0; bj < 2; ++bj)
#pragma unroll
                    for (int n = 0; n < 2; ++n) { const f32x4 zi = *(const f32x4*)(zin + off + bj * HALF + n * 16);
                        const f32x4 x = (zi - mu) * rstd * lg[bj][n] + lb[bj][n];
                        *(f32x4*)(zout + off + bj * HALF + n * 16) = x * alpha + gv[bj][n] * acc[ai][bj][m][n]; }
                if (m & 1) asm volatile("" ::: "memory"); }
    }
};

template <class Epi, class Sched, bool ALIGN_EPI = false, bool SP2 = false>
__device__ __forceinline__ void gemm_phase(PG8_LAS unsigned char* lds, const Gemm g, const Sched& S, const Epi& E) {
    int tid_ = threadIdx.x; asm volatile("" : "+v"(tid_));
    const int tid = tid_, wid = __builtin_amdgcn_readfirstlane(tid >> 6), lane = tid & 63, wr = wid >> 2, wc = wid & 3, fr = lane & 15, fq = lane >> 4;
    const int K = g.K, nt = K / BK;
    unsigned voffA[2], voffB[2];
#pragma unroll
    for (int i = 0; i < 2; ++i) { int R, C; stage_rc(tid * 16 + i * 8192, R, C); const int Rb = Epi::PERM ? ((R & ~31) + perm32(R & 31)) : R;
        voffA[i] = (unsigned)(R * g.lda + C) * 2u; voffB[i] = (unsigned)(Rb * K + C) * 2u; }
    const size_t kstep = (size_t)(BK * 2);
    const size_t hstepA = (size_t)HALF * g.lda * 2, hstepB = (size_t)HALF * K * 2;
    const size_t tstepA = 2 * hstepA, tstepB = 2 * hstepB;
    const unsigned ldsw = (unsigned)wid * 1024u;
    const int aoff = lds_byte(wr * 64 + fr, fq * 8), boff = lds_byte(wc * 32 + fr, fq * 8);
#define PG8_SA(b, h) (((b) * 2 + (h)) * HTB)
#define PG8_SB(b, h) ((4 + (b) * 2 + (h)) * HTB)
#define PG8_STAGE(bufoff, gbase, voff) do { _Pragma("unroll") for (int _i = 0; _i < 2; ++_i) \
        __builtin_amdgcn_global_load_lds((const unsigned*)((const char*)(gbase) + (voff)[_i]), (PG8_LAS unsigned*)(lds + (bufoff) + ldsw + _i * 8192), 16, 0, 0); } while (0)
#define PG8_LDA(dst, b, h) do { _Pragma("unroll") for (int m = 0; m < 4; ++m) _Pragma("unroll") for (int k = 0; k < 2; ++k) dst[m][k] = *(const PG8_LAS bf16x8*)(lds + PG8_SA(b, h) + aoff + m * 2048 + k * 1024); } while (0)
#define PG8_LDB(dst, b, h) do { _Pragma("unroll") for (int n = 0; n < 2; ++n) _Pragma("unroll") for (int k = 0; k < 2; ++k) dst[n][k] = *(const PG8_LAS bf16x8*)(lds + PG8_SB(b, h) + boff + n * 2048 + k * 1024); } while (0)
#define PG8_MMA(ai, bj, At, Bt) do { __builtin_amdgcn_s_setprio(1); _Pragma("unroll") for (int m = 0; m < 4; ++m) _Pragma("unroll") for (int n = 0; n < 2; ++n) _Pragma("unroll") for (int k = 0; k < 2; ++k) \
        acc[ai][bj][m][n] = __builtin_amdgcn_mfma_f32_16x16x32_bf16(Bt[n][k], At[m][k], acc[ai][bj][m][n], 0, 0, 0); __builtin_amdgcn_s_setprio(0); } while (0)
#define PG8_WAIT_V(n) asm volatile("s_waitcnt vmcnt(" #n ")" ::: "memory")
#define PG8_WAIT_L(n) asm volatile("s_waitcnt lgkmcnt(" #n ")" ::: "memory")
#define PG8_BAR __builtin_amdgcn_s_barrier()
#define PG8_SCHED __builtin_amdgcn_sched_barrier(0)
    Unit cur, nxt; int ui = 0;
    if (!S.next(0, cur)) return;
    f32x4 acc[2][2][4][2];
#pragma unroll
    for (int a = 0; a < 2; ++a)
#pragma unroll
        for (int b = 0; b < 2; ++b)
#pragma unroll
            for (int m = 0; m < 4; ++m)
#pragma unroll
                for (int n = 0; n < 2; ++n) acc[a][b][m][n] = (f32x4){0.f, 0.f, 0.f, 0.f};
    bf16x8 At[4][2], B0[2][2], B1[2][2];
    const char* cA = (const char*)g.A + (size_t)cur.pm * tstepA + (size_t)cur.pn * g.a_pn_off; const char* cB = (const char*)g.Bt + (size_t)cur.pn * tstepB;
    S.a_ready(cur);
    if constexpr (SP2) {
        PG8_STAGE(PG8_SB(0, 0), cB, voffB); PG8_STAGE(PG8_SB(0, 1), cB + hstepB, voffB); PG8_STAGE(PG8_SA(0, 0), cA, voffA); PG8_STAGE(PG8_SA(0, 1), cA + hstepA, voffA);
        if (wr == 1) PG8_BAR;
        PG8_WAIT_V(2); PG8_BAR;
        PG8_STAGE(PG8_SB(1, 0), cB + kstep, voffB); PG8_STAGE(PG8_SA(1, 0), cA + kstep, voffA); PG8_STAGE(PG8_SB(1, 1), cB + hstepB + kstep, voffB);
        PG8_WAIT_V(6); PG8_BAR;
    } else {
        PG8_STAGE(PG8_SB(0, 0), cB, voffB); PG8_STAGE(PG8_SA(0, 0), cA, voffA); PG8_STAGE(PG8_SB(0, 1), cB + hstepB, voffB); PG8_STAGE(PG8_SA(0, 1), cA + hstepA, voffA);
        if (wr == 1) PG8_BAR;
        PG8_WAIT_V(4); PG8_BAR;
        PG8_STAGE(PG8_SB(1, 0), cB + kstep, voffB); PG8_STAGE(PG8_SA(1, 0), cA + kstep, voffA); PG8_STAGE(PG8_SB(1, 1), cB + hstepB + kstep, voffB);
        PG8_WAIT_V(6); PG8_BAR;
    }
    for (;;) {
        const bool has_next = S.next(ui + 1, nxt);
        const char* nA = has_next ? (const char*)g.A + (size_t)nxt.pm * tstepA + (size_t)nxt.pn * g.a_pn_off : cA; const char* nB = has_next ? (const char*)g.Bt + (size_t)nxt.pn * tstepB : cB;
        for (int t = 0; t < nt; t += 2) {
            const bool last = (t == nt - 2);
            const char* a1 = cA + (size_t)(t + 1) * kstep;
            const char* a2 = last ? nA : cA + (size_t)(t + 2) * kstep; const char* b2 = last ? nB : cB + (size_t)(t + 2) * kstep;
            const char* a3 = a2 + kstep; const char* b3 = b2 + kstep;
            if (last && has_next) S.a_ready(nxt);
            if constexpr (SP2) {
            PG8_LDB(B0, 0, 0); PG8_LDB(B1, 0, 1); PG8_SCHED; PG8_LDA(At, 0, 0); PG8_STAGE(PG8_SA(1, 1), a1 + hstepA, voffA);
            PG8_WAIT_V(8); PG8_WAIT_L(0); PG8_BAR; PG8_MMA(0, 0, At, B0); PG8_MMA(0, 1, At, B1); PG8_BAR; PG8_SCHED;
            PG8_LDA(At, 0, 1); PG8_STAGE(PG8_SB(0, 0), b2, voffB); PG8_STAGE(PG8_SB(0, 1), b2 + hstepB, voffB); PG8_STAGE(PG8_SA(0, 0), a2, voffA);
            PG8_WAIT_V(8); PG8_WAIT_L(0); PG8_BAR; PG8_MMA(1, 0, At, B0); PG8_MMA(1, 1, At, B1); PG8_BAR; PG8_SCHED;
            PG8_LDB(B0, 1, 0); PG8_LDB(B1, 1, 1); PG8_SCHED; PG8_LDA(At, 1, 0); PG8_STAGE(PG8_SA(0, 1), a2 + hstepA, voffA);
            PG8_WAIT_V(8); PG8_WAIT_L(0); PG8_BAR; PG8_MMA(0, 0, At, B0); PG8_MMA(0, 1, At, B1); PG8_BAR; PG8_SCHED;
            PG8_LDA(At, 1, 1); PG8_STAGE(PG8_SB(1, 0), b3, voffB); PG8_STAGE(PG8_SB(1, 1), b3 + hstepB, voffB); PG8_STAGE(PG8_SA(1, 0), a3, voffA);
            PG8_WAIT_V(8); PG8_WAIT_L(0); PG8_BAR; PG8_MMA(1, 0, At, B0); PG8_MMA(1, 1, At, B1); PG8_BAR; PG8_SCHED;
            } else {
            PG8_LDB(B0, 0, 0); PG8_SCHED; PG8_LDA(At, 0, 0); PG8_STAGE(PG8_SA(1, 1), a1 + hstepA, voffA);
            PG8_WAIT_L(8); PG8_BAR; PG8_WAIT_L(0); PG8_MMA(0, 0, At, B0); PG8_BAR; PG8_SCHED;
            PG8_LDB(B1, 0, 1); PG8_STAGE(PG8_SB(0, 0), b2, voffB);
            PG8_BAR; PG8_WAIT_L(0); PG8_MMA(0, 1, At, B1); PG8_BAR;
            PG8_LDA(At, 0, 1); PG8_STAGE(PG8_SA(0, 0), a2, voffA);
            PG8_BAR; PG8_WAIT_L(0); PG8_MMA(1, 0, At, B0); PG8_BAR; PG8_SCHED;
            PG8_STAGE(PG8_SB(0, 1), b2 + hstepB, voffB);
            PG8_WAIT_V(6); PG8_BAR; PG8_MMA(1, 1, At, B1); PG8_BAR;
            PG8_LDB(B0, 1, 0); PG8_SCHED; PG8_LDA(At, 1, 0); PG8_STAGE(PG8_SA(0, 1), a2 + hstepA, voffA);
            PG8_WAIT_L(8); PG8_BAR; PG8_WAIT_L(0); PG8_MMA(0, 0, At, B0); PG8_BAR; PG8_SCHED;
            PG8_LDB(B1, 1, 1); PG8_STAGE(PG8_SB(1, 0), b3, voffB);
            PG8_BAR; PG8_WAIT_L(0); PG8_MMA(0, 1, At, B1); PG8_BAR;
            PG8_LDA(At, 1, 1); PG8_STAGE(PG8_SA(1, 0), a3, voffA);
            PG8_BAR; PG8_WAIT_L(0); PG8_MMA(1, 0, At, B0); PG8_BAR; PG8_SCHED;
            PG8_STAGE(PG8_SB(1, 1), b3 + hstepB, voffB);
            PG8_WAIT_V(6); PG8_BAR; PG8_MMA(1, 1, At, B1); PG8_BAR;
            }
        }
        if constexpr (ALIGN_EPI) { if (wr == 0) PG8_BAR; }
        if constexpr (!Epi::AFTER_DRAIN) { E(acc, cur, wr, wc, fr, fq); S.done(cur); }
        if (!has_next) break;
#pragma unroll
        for (int a = 0; a < 2; ++a)
#pragma unroll
            for (int b = 0; b < 2; ++b)
#pragma unroll
                for (int m = 0; m < 4; ++m)
#pragma unroll
                    for (int n = 0; n < 2; ++n) acc[a][b][m][n] = (f32x4){0.f, 0.f, 0.f, 0.f};
        cur = nxt; cA = nA; cB = nB; ++ui;
        if constexpr (ALIGN_EPI) { if (wr == 1) PG8_BAR; }
    }
    PG8_WAIT_V(0);
    if constexpr (!ALIGN_EPI) { if (wr == 0) PG8_BAR; }
    PG8_BAR;
    if constexpr (Epi::AFTER_DRAIN) { E.fused(acc, cur, wr, wc, fr, fq, lds, wid, lane); S.done(cur); }
#undef PG8_SA
#undef PG8_SB
#undef PG8_STAGE
#undef PG8_LDA
#undef PG8_LDB
#undef PG8_MMA
#undef PG8_WAIT_V
#undef PG8_WAIT_L
#undef PG8_BAR
#undef PG8_SCHED
}
}

namespace att {
typedef unsigned short bf16;
typedef short bf16x8 __attribute__((ext_vector_type(8)));
typedef short s16x4 __attribute__((ext_vector_type(4)));
typedef float f32x16 __attribute__((ext_vector_type(16)));
typedef float f32x4 __attribute__((ext_vector_type(4)));
typedef unsigned u32x4 __attribute__((ext_vector_type(4)));
constexpr int NW = 8, QBLK = 32, KVBLK = 64, QB = NW * QBLK;
constexpr int QS = 1536, KS = 1536, VS = 1024, OS = 1024;
constexpr int SHM_V = KVBLK * 128 * 2, SHM_K = KVBLK * 192 * 2;
constexpr int QR_OFF = 2 * SHM_V + 2 * SHM_K + NW * 64 * 4;
constexpr int LDS_BYTES = QR_OFF + NW * 4096;
constexpr float SCALE = 0.07216878364870322f;
constexpr float THR = 8.f;

#define KSWZ(row, colB) ((row) * 384 + ((colB) ^ (((row) & 7) << 4)))
#define SBAR() __builtin_amdgcn_sched_barrier(0)
__device__ __forceinline__ int v_st(int k, int c) { const int kk = (k & ~0xC) | ((k & 4) << 1) | ((k & 8) >> 1); return ((kk >> 3) * 4 + (c >> 5)) * 512 + ((kk & 7) * 32 + (c & 31)) * 2; }
__device__ __forceinline__ int v_rd_base(int lane) { return ((lane & 3) << 3) | (((lane >> 2) & 3) << 6) | (((lane >> 4) & 1) << 5) | (((lane >> 5) & 1) << 8); }
constexpr int v_rd_off(int d0, int ks, int half) { return d0 * 512 + ks * 4096 + half * 2048; }
__device__ __forceinline__ int crow(int r, int hi) { return (r & 3) + 8 * (r >> 2) + 4 * hi; }
__device__ __forceinline__ unsigned cvtpk(float lo, float hi) { unsigned r; asm volatile("v_cvt_pk_bf16_f32 %0, %1, %2" : "=v"(r) : "v"(lo), "v"(hi)); return r; }
__device__ __forceinline__ bf16x8 ld8(const bf16* p) { return *reinterpret_cast<const bf16x8*>(p); }
__device__ __forceinline__ void mask_tile(f32x16& p0, f32x16& p1, int dq, unsigned W) {
    const float NEG = -__builtin_inff();
#pragma unroll
    for (int r = 0; r < 16; ++r) {
        const int c = (r & 3) + 8 * (r >> 2);
        if ((unsigned)(dq - c) >= W) p0[r] = NEG;
        if ((unsigned)(dq - c - 32) >= W) p1[r] = NEG;
    }
}
__device__ __forceinline__ void partialSM(f32x16& p0, f32x16& p1, float& m_reg, float& mn, float& alpha) {
    float pmax = p0[0]; for (int r = 1; r < 16; ++r) pmax = fmaxf(pmax, p0[r]); for (int r = 0; r < 16; ++r) pmax = fmaxf(pmax, p1[r]);
    { auto rr = __builtin_amdgcn_permlane32_swap(__float_as_uint(pmax), __float_as_uint(pmax), false, false);
      pmax = fmaxf(__uint_as_float(rr[0]), __uint_as_float(rr[1])); }
    constexpr float C2 = 1.4426950408889634f * SCALE;
    if (__builtin_expect(__all((pmax - m_reg) * SCALE <= THR), 1)) { mn = m_reg; alpha = 1.f; }
    else { mn = fmaxf(m_reg, pmax); alpha = __builtin_amdgcn_exp2f((m_reg - mn) * C2); m_reg = mn; }
    const float mnL = -mn * C2;
    for (int r = 0; r < 16; ++r) p0[r] = fmaf(p0[r], C2, mnL); for (int r = 0; r < 16; ++r) p1[r] = fmaf(p1[r], C2, mnL);
    for (int r = 0; r < 16; ++r) p0[r] = __builtin_amdgcn_exp2f(p0[r]);
}
__device__ __forceinline__ void finishSM(f32x16& p0, f32x16& p1, float alpha, float& l_reg, bf16x8& pa0, bf16x8& pa1, bf16x8& pa2, bf16x8& pa3) {
    for (int r = 0; r < 16; ++r) p1[r] = __builtin_amdgcn_exp2f(p1[r]);
    float ps = 0; for (int r = 0; r < 16; ++r) ps += p0[r]; for (int r = 0; r < 16; ++r) ps += p1[r];
    { auto rr = __builtin_amdgcn_permlane32_swap(__float_as_uint(ps), __float_as_uint(ps), false, false);
      ps = __uint_as_float(rr[0]) + __uint_as_float(rr[1]); }
    l_reg = l_reg * alpha + ps;
#define PK4(P, B_, OUT) do { unsigned a0 = cvtpk(P[B_+0], P[B_+1]), a1 = cvtpk(P[B_+2], P[B_+3]);                          \
        unsigned b0 = cvtpk(P[B_+4], P[B_+5]), b1 = cvtpk(P[B_+6], P[B_+7]);                                             \
        auto r0 = __builtin_amdgcn_permlane32_swap(a0, b0, false, false); auto r1 = __builtin_amdgcn_permlane32_swap(a1, b1, false, false); \
        u32x4 w = {r0[0], r1[0], r0[1], r1[1]}; OUT = *reinterpret_cast<bf16x8*>(&w); } while (0)
    PK4(p0, 0, pa0); PK4(p0, 8, pa1); PK4(p1, 0, pa2); PK4(p1, 8, pa3);
#undef PK4
}
template <int KB>
__device__ __forceinline__ void qkt(f32x16& p0, f32x16& p1, const char* K_lds, int r32, int hi, const bf16x8* qr, const char* qrl) {
    p0 = f32x16{}; p1 = f32x16{};
    const char* kb[4];
#pragma unroll
    for (int dd = 0; dd < 4; ++dd) kb[dd] = K_lds + KB * SHM_K + KSWZ(r32, (dd * 16 + hi * 8) * 2);
#pragma unroll
    for (int d0 = 0; d0 < 12; ++d0) { const char* a = kb[d0 & 3] + (d0 >> 2) * 128;
        bf16x8 b0 = *reinterpret_cast<const bf16x8*>(a);
        bf16x8 b1 = *reinterpret_cast<const bf16x8*>(a + 32 * 384);
        const bf16x8 qd = (d0 < 8) ? qr[d0 < 8 ? d0 : 0] : *reinterpret_cast<const bf16x8*>(qrl + (d0 - 8) * 1024);
        p0 = __builtin_amdgcn_mfma_f32_32x32x16_bf16(b0, qd, p0, 0, 0, 0);
        p1 = __builtin_amdgcn_mfma_f32_32x32x16_bf16(b1, qd, p1, 0, 0, 0);
        if ((d0 & 1) == 1 && d0 != 11) SBAR(); }
}
template <int VB>
__device__ __forceinline__ void pv_tile(f32x16* o, int vb0, bf16x8 pa0, bf16x8 pa1, bf16x8 pa2, bf16x8 pa3) {
#define TRRD(dst, off) asm volatile("ds_read_b64_tr_b16 %0, %1 offset:%2" : "=&v"(dst) : "v"(vb0), "i"(off) : "memory")
#define PV_D0(d0) do { s16x4 l0, l1, l2, l3, h0, h1, h2, h3; constexpr int b_ = VB * SHM_V + v_rd_off(d0, 0, 0);   \
        TRRD(l0, b_); TRRD(h0, b_ + 2048); TRRD(l1, b_ + 4096); TRRD(h1, b_ + 6144); TRRD(l2, b_ + 8192); TRRD(h2, b_ + 10240); TRRD(l3, b_ + 12288); TRRD(h3, b_ + 14336); \
        asm volatile("s_waitcnt lgkmcnt(0)" ::: "memory"); SBAR();                                                        \
        o[d0] = __builtin_amdgcn_mfma_f32_32x32x16_bf16(pa0, (bf16x8){l0[0], l0[1], l0[2], l0[3], h0[0], h0[1], h0[2], h0[3]}, o[d0], 0, 0, 0);   \
        o[d0] = __builtin_amdgcn_mfma_f32_32x32x16_bf16(pa1, (bf16x8){l1[0], l1[1], l1[2], l1[3], h1[0], h1[1], h1[2], h1[3]}, o[d0], 0, 0, 0);   \
        o[d0] = __builtin_amdgcn_mfma_f32_32x32x16_bf16(pa2, (bf16x8){l2[0], l2[1], l2[2], l2[3], h2[0], h2[1], h2[2], h2[3]}, o[d0], 0, 0, 0);   \
        o[d0] = __builtin_amdgcn_mfma_f32_32x32x16_bf16(pa3, (bf16x8){l3[0], l3[1], l3[2], l3[3], h3[0], h3[1], h3[2], h3[3]}, o[d0], 0, 0, 0); } while (0)
    PV_D0(0); PV_D0(1); PV_D0(2); PV_D0(3);
#undef PV_D0
#undef TRRD
}

struct BlockRef { const bf16* Q; const bf16* K; const bf16* V; bf16* O; int P0; };
struct Seam { bf16x8 qr[8]; bf16x8 st_v0, st_v1, st_k0, st_k1, st_k2; };
#define KT(p, k0) ((p) + (size_t)(k0) * KS)
#define VT(p, k0) ((p) + (size_t)(k0) * VS)
#define VMW() asm volatile("s_waitcnt vmcnt(0)" ::: "memory")
#define VMWN(n) asm volatile("s_waitcnt vmcnt(%0)" :: "i"(n) : "memory")
#define SLOAD_H(Kp, Vp, k0) do { const bf16* vt_ = VT(Vp, k0); const bf16* vt2_ = vt_ + 32 * VS; const bf16* kt_ = KT(Kp, k0);                  \
                         S.st_v0 = ld8(vt_ + voff); S.st_v1 = ld8(vt2_ + voff);              \
                         S.st_k0 = ld8(kt_ + koff); S.st_k1 = ld8(kt_ + koff + 64); S.st_k2 = ld8(kt_ + koff + 128); } while (0)
#define SWRITE_HK(bf) do { *(bf16x8*)(K_lds + (bf) * SHM_K + kws) = S.st_k0; *(bf16x8*)(K_lds + (bf) * SHM_K + kws + 128) = S.st_k1; *(bf16x8*)(K_lds + (bf) * SHM_K + kws + 256) = S.st_k2; } while (0)
#define SWRITE_HV(bf) do { *(bf16x8*)(V_lds + (bf) * SHM_V + vst0) = S.st_v0; *(bf16x8*)(V_lds + (bf) * SHM_V + vst1) = S.st_v1; } while (0)
#define SWRITE_H(bf) do { SWRITE_HV(bf); SWRITE_HK(bf); } while (0)
__device__ __forceinline__ void causal_prime(const BlockRef& cur, char* lds, Seam& S) {
    int tid_ = threadIdx.x; asm volatile("" : "+v"(tid_));
    const int tid = tid_, wid = __builtin_amdgcn_readfirstlane(tid >> 6), lane = tid & 63, r32 = lane & 31, hi = lane >> 5;
    const int sr = tid >> 4, sc = (tid & 15) * 8, kr = tid >> 3, kc = (tid & 7) * 8, kws = KSWZ(kr, kc * 2); char* K_lds = lds + 2 * SHM_V;
    const unsigned voff = (unsigned)(sr * VS + sc), koff = (unsigned)(kr * KS + kc), qoff = (unsigned)((wid * QBLK + r32) * QS + hi * 8);
    const int kb0 = 0;
#pragma unroll
    for (int d0 = 0; d0 < 8; ++d0) S.qr[d0] = ld8(cur.Q + qoff + d0 * 16);
    { char* qrl = lds + QR_OFF + wid * 4096 + lane * 16;
#pragma unroll
      for (int d0 = 0; d0 < 4; ++d0) *(bf16x8*)(qrl + d0 * 1024) = ld8(cur.Q + qoff + 128 + d0 * 16); }
    SLOAD_H(cur.K, cur.V, kb0); VMW(); SWRITE_HK(0);
    __syncthreads();
}
__device__ __forceinline__ void causal_block(const BlockRef& cur, const BlockRef& nxt, char* lds, Seam& S) {
    int tid_ = threadIdx.x; asm volatile("" : "+v"(tid_));
    const int tid = tid_, wid = __builtin_amdgcn_readfirstlane(tid >> 6), lane = tid & 63, r32 = lane & 31, hi = lane >> 5;
    constexpr int W = 1 << 30;
    const int NT = (cur.P0 + QB - 1) / KVBLK + 1;
    const int kbn = 0;
    const int qlo = cur.P0 + wid * QBLK, qm = qlo + r32 - 4 * hi;
    char* V_lds = lds; char* K_lds = lds + 2 * SHM_V;
    float* ws = (float*)(lds + 2 * SHM_V + 2 * SHM_K) + wid * 64; float* li_l = ws, * al_l = ws + 32;
    float m_reg = -1e30f, l_reg = 0; f32x16 o[4] = {};
    const int sr = tid >> 4, sc = (tid & 15) * 8, vst0 = v_st(sr, sc), vst1 = v_st(32 + sr, sc);
    const int kr = tid >> 3, kc = (tid & 7) * 8, kws = KSWZ(kr, kc * 2);
    const unsigned voff = (unsigned)(sr * VS + sc), koff = (unsigned)(kr * KS + kc), qoff = (unsigned)((wid * QBLK + r32) * QS + hi * 8);
    const int vb0 = (int)(uintptr_t)V_lds + v_rd_base(lane);
    char* qrl = lds + QR_OFF + wid * 4096 + lane * 16;
    const bf16* Kh = cur.K; const bf16* Vh = cur.V;
#define RESC(a) do { if (__any((a) < 1.f)) { if (hi == 0) al_l[r32] = (a); asm volatile("s_waitcnt lgkmcnt(0)" ::: "memory");              \
                     for (int d_ = 0; d_ < 4; ++d_) for (int r = 0; r < 16; ++r) o[d_][r] *= al_l[crow(r, hi)]; } } while (0)
#define KBASE(t) ((t) * KVBLK)
#define MASKT(P0_, P1_, t) do { const int kb_ = KBASE(t); if (kb_ + KVBLK - 1 > qlo) mask_tile(P0_, P1_, qm - kb_, (unsigned)W); } while (0)
    constexpr int NQL = 8;
#define SEAM_K0() do { VMWN(NQL); SWRITE_HK(0); SBAR(); } while (0)
    f32x16 pA0, pA1, pB0, pB1; float mnA, mnB, alA, alB; bf16x8 pa0, pa1, pa2, pa3;
    SWRITE_HV(0); SBAR();
    if (NT > 1) SLOAD_H(Kh, Vh, KBASE(1));
    SBAR(); qkt<0>(pA0, pA1, K_lds, r32, hi, S.qr, qrl);
    MASKT(pA0, pA1, 0); partialSM(pA0, pA1, m_reg, mnA, alA);
    if (NT > 1) { VMW(); SWRITE_H(1); }
    __syncthreads();
#define HALF_STEP(PX0, PX1, mnX, alX, PY0, PY1, alY, t, KB, VB, SB) do {                                                      \
        SBAR(); qkt<KB>(PX0, PX1, K_lds, r32, hi, S.qr, qrl);                                                                       \
        finishSM(PY0, PY1, alY, l_reg, pa0, pa1, pa2, pa3); SBAR();                                                           \
        if ((t) + 1 < NT) { SLOAD_H(Kh, Vh, KBASE((t) + 1)); SBAR(); }                                                        \
        pv_tile<VB>(o, vb0, pa0, pa1, pa2, pa3); MASKT(PX0, PX1, (t)); partialSM(PX0, PX1, m_reg, mnX, alX);                  \
        __syncthreads();                                                                                                      \
        if ((t) + 1 < NT) { VMW(); SWRITE_H(SB); }                                                                            \
        RESC(alX); __syncthreads(); } while (0)
    for (int t = 1; t + 1 < NT; t += 2) {
        HALF_STEP(pB0, pB1, mnB, alB, pA0, pA1, alA, t, 1, 0, 0);
        HALF_STEP(pA0, pA1, mnA, alA, pB0, pB1, alB, t + 1, 0, 1, 1);
    }
    const bool even = (NT & 1) == 0;
    if (even) { SBAR(); qkt<1>(pB0, pB1, K_lds, r32, hi, S.qr, qrl); SBAR(); }
    SLOAD_H(nxt.K, nxt.V, kbn); SBAR();
#pragma unroll
    for (int d0 = 0; d0 < 8; ++d0) S.qr[d0] = ld8(nxt.Q + qoff + d0 * 16);
    SBAR();
    finishSM(pA0, pA1, alA, l_reg, pa0, pa1, pa2, pa3); SBAR();
    pv_tile<0>(o, vb0, pa0, pa1, pa2, pa3);
    if (even) { MASKT(pB0, pB1, NT - 1); partialSM(pB0, pB1, m_reg, mnB, alB); __syncthreads(); RESC(alB);
        finishSM(pB0, pB1, alB, l_reg, pa0, pa1, pa2, pa3); SBAR(); pv_tile<1>(o, vb0, pa0, pa1, pa2, pa3); }
    SBAR(); SEAM_K0();
    const bf16x8 tq0 = ld8(nxt.Q + qoff + 128), tq1 = ld8(nxt.Q + qoff + 144), tq2 = ld8(nxt.Q + qoff + 160), tq3 = ld8(nxt.Q + qoff + 176);
    SBAR();
    if (hi == 0) li_l[r32] = l_reg; asm volatile("s_waitcnt lgkmcnt(0)" ::: "memory");
    float rli[16];
#pragma unroll
    for (int r = 0; r < 16; ++r) rli[r] = __builtin_amdgcn_rcpf(li_l[crow(r, hi)]);
    bf16* Ow = cur.O + (size_t)(wid * QBLK) * OS;
#pragma unroll
    for (int r = 0; r < 16; ++r) { const int orow = crow(r, hi);
#pragma unroll
        for (int d0 = 0; d0 < 4; ++d0) { const float v = o[d0][r] * rli[r];
            const float vn = __builtin_bit_cast(float, __builtin_amdgcn_ds_swizzle(__builtin_bit_cast(int, v), (1 << 10) | 0x1f));
            if ((r32 & 1) == 0) *(unsigned*)(Ow + (size_t)orow * OS + d0 * 32 + r32) = cvtpk(v, vn); } }
    SBAR();
    *(bf16x8*)(qrl) = tq0; *(bf16x8*)(qrl + 1024) = tq1; *(bf16x8*)(qrl + 2048) = tq2; *(bf16x8*)(qrl + 3072) = tq3;
    __syncthreads();
#undef RESC
#undef KBASE
#undef MASKT
#undef SEAM_K0
#undef HALF_STEP
}
#undef KT
#undef VT
#undef VMW
#undef VMWN
#undef SLOAD_H
#undef SWRITE_HK
#undef SWRITE_HV
#undef SWRITE_H
}

namespace mk {
typedef unsigned short bf16;
typedef float f32x4 __attribute__((ext_vector_type(4)));
typedef float f32x2 __attribute__((ext_vector_type(2)));
typedef unsigned u32x4 __attribute__((ext_vector_type(4)));
typedef unsigned u32x2 __attribute__((ext_vector_type(2)));
constexpr int NB = 16, S = 4096, T = NB * S, D = 1024, FF = 4096, NH = 8, QR = 512, KVR = 256, NL = 4;
constexpr float ALPHA = 1.6817928305074290f;
constexpr float LN_EPS = 1e-5f, RMS_EPS = 1e-6f;
constexpr int NTHREADS = 512, NWAVES = 8;
constexpr int LDS_BYTES = 147456;
constexpr int MISC_OFF = 131072 + 4096;
constexpr size_t MiB = 1u << 20;
constexpr size_t WS_W1T = 0, WS_W2T = 32 * MiB, WS_PWT = 64 * MiB, WS_QDT = 65 * MiB, WS_QUT = 67 * MiB, WS_AOT = 70 * MiB, WS_KVINT = 74 * MiB, WS_KVUT = 75 * MiB;
constexpr size_t WS_MOD = 76 * MiB, WS_ST = 78 * MiB, WS_RQ = 78 * MiB + 512 * 1024, WS_RKV = 78 * MiB + 768 * 1024, WS_CS = 80 * MiB;
constexpr size_t WS_K = 96 * MiB, WS_V = 288 * MiB, WS_H = 416 * MiB, WS_ACT = 544 * MiB, WS_XB = 544 * MiB, WS_Q = 544 * MiB, WS_CKR = 800 * MiB, WS_CQ = 864 * MiB, WS_CTL = 928 * MiB, CTL_BYTES = 65536, WS_END = 929 * MiB;
constexpr int HALF_T = T / 2;

struct Params {
    const float* x; const float* c; const int* pos; const float* ada_w; const float* ada_b; const float* ln_g; const float* ln_b; const float* w1; const float* w2;
    const float* pool_w; const float* pool_scale; const float* q_down; const float* q_norm_g; const float* q_up; const float* attn_out; const float* kv_in; const float* kv_norm_g;
    const float* k_up; const float* v_up; float* out; unsigned char* ws;
};

__device__ __forceinline__ unsigned f2bf(float f) { unsigned u = __builtin_bit_cast(unsigned, f); return (u + 0x7fffu + ((u >> 16) & 1u)) >> 16; }
__device__ __forceinline__ unsigned pk2(float lo, float hi) { return f2bf(lo) | (f2bf(hi) << 16); }
__device__ __forceinline__ float bf2f(unsigned short h) { return __builtin_bit_cast(float, (unsigned)h << 16); }
#define SWZ_XOR(v, o) __builtin_bit_cast(float, __builtin_amdgcn_ds_swizzle(__builtin_bit_cast(int, (v)), ((o) << 10) | 0x1f))
__device__ __forceinline__ float wave_sum(float v) {
    v += SWZ_XOR(v, 1); v += SWZ_XOR(v, 2); v += SWZ_XOR(v, 4); v += SWZ_XOR(v, 8); v += SWZ_XOR(v, 16);
    { auto rr = __builtin_amdgcn_permlane32_swap(__float_as_uint(v), __float_as_uint(v), false, false); v = __uint_as_float(rr[0]) + __uint_as_float(rr[1]); }
    return v;
}

#define LAS __attribute__((address_space(3)))
#define XB_TMO      128
#define XB_XCNT(j)  (256  + 64 * (j))
#define XB_XSUB(j)  (1280 + 64 * (j))
#define XB_XGEN(j)  (2304 + 64 * (j))
#define XB_TOP      3328
#define XB_TOPGEN   3392
#define XCD_BAR_WORDS 3456
#define XB_SPIN_CAP (1u << 18)

__device__ __forceinline__ unsigned xb_ld(unsigned* p)              { return __hip_atomic_load(p, __ATOMIC_RELAXED, __HIP_MEMORY_SCOPE_AGENT); }
__device__ __forceinline__ unsigned xb_add(unsigned* p, unsigned v) { return __hip_atomic_fetch_add(p, v, __ATOMIC_RELAXED, __HIP_MEMORY_SCOPE_AGENT); }
__device__ __forceinline__ unsigned xb_xcc_id() { return (unsigned)__builtin_amdgcn_s_getreg((3 << 11) | 20) & 0xFu; }
#define XB_SPIN(cond, bar) do { unsigned _sp = 0; while (cond) { __builtin_amdgcn_s_sleep(1); \
    if ((++_sp & 255u) == 0u) { if (xb_ld(&(bar)[XB_TMO])) break; if (_sp > XB_SPIN_CAP) { atomicAdd(&(bar)[XB_TMO], 1u); break; } } } } while (0)

struct XcdBarrier {
    unsigned* bar; unsigned x;
    volatile LAS unsigned* st;
};

__device__ __forceinline__ XcdBarrier xcd_barrier_post(unsigned* bar, volatile LAS unsigned* st) {
    XcdBarrier b; b.bar = bar; b.x = xb_xcc_id(); b.st = st;
    if (threadIdx.x == 0) (void)xb_add(&bar[XB_XCNT(b.x)], 1u);
    return b;
}
__device__ __forceinline__ void xcd_barrier_complete(unsigned* bar, unsigned x, unsigned& nloc, unsigned& nx) {
    const unsigned G = gridDim.x * gridDim.y * gridDim.z;
    unsigned sum, cnt, mine, sp = 0u;
    for (;;) {
        sum = 0u; cnt = 0u; mine = 0u;
#pragma unroll
        for (unsigned j = 0; j < 16; ++j) { const unsigned c = xb_ld(&bar[XB_XCNT(j)]); sum += c; cnt += (c > 0u) ? 1u : 0u; mine = (j == x) ? c : mine; }
        if (sum == G) break;
        __builtin_amdgcn_s_sleep(1);
        if ((++sp & 255u) == 0u) { if (xb_ld(&bar[XB_TMO])) break; if (sp > XB_SPIN_CAP) { atomicAdd(&bar[XB_TMO], 1u); break; } }
    }
    nloc = mine > 0u ? mine : 1u; nx = cnt > 0u ? cnt : 1u;
}

__device__ __forceinline__ void xcd_barrier(const XcdBarrier& b) {
    asm volatile("s_waitcnt vmcnt(0)" ::: "memory");
    __syncthreads();
    if (threadIdx.x == 0) {
        unsigned* bar = b.bar;
        __builtin_amdgcn_s_waitcnt(0);
        unsigned nloc = b.st[0], nx = b.st[1];
        if (nloc == 0u) { xcd_barrier_complete(bar, b.x, nloc, nx); b.st[0] = nloc; b.st[1] = nx; }
        const unsigned old = xb_add(&bar[XB_XSUB(b.x)], 1u);
        const unsigned gen = old / nloc;
        if (old + 1u == (gen + 1u) * nloc) {
            __builtin_amdgcn_fence(__ATOMIC_RELEASE, "agent");
            asm volatile("s_waitcnt vmcnt(0)" ::: "memory");
            const unsigned og = xb_add(&bar[XB_TOP], 1u);
            const unsigned tg = og / nx;
            if (og + 1u == (tg + 1u) * nx) xb_add(&bar[XB_TOPGEN], 1u);
            else XB_SPIN(xb_ld(&bar[XB_TOPGEN]) == tg, bar);
            __builtin_amdgcn_fence(__ATOMIC_ACQUIRE, "agent");
            xb_add(&bar[XB_XGEN(b.x)], 1u);
            asm volatile("s_waitcnt vmcnt(0)" ::: "memory");
        } else {
            XB_SPIN(xb_ld(&bar[XB_XGEN(b.x)]) == gen, bar);
            __builtin_amdgcn_fence(__ATOMIC_ACQUIRE, "agent");
            asm volatile("s_waitcnt vmcnt(0)" ::: "memory");
        }
    }
    __syncthreads();
}

__device__ __forceinline__ int map_row(int map, int n) {
    if (map == 0) return n;
    const int h = n / 192, d = n - h * 192;
    if (d < 128) return h * 128 + d;
    const int rd = d - 128, half = rd >> 5, i = rd & 31;
    return 1024 + h * 64 + (i >> 2) * 8 + half * 4 + (i & 3);
}
__device__ __forceinline__ void transpose_item(const float* W, int K, int N, bf16* WT, int row_off, int map, const float* kscale, float* scr, int item, int lane) {
    const int nblk = N / 32, kb = item / nblk, nb = item % nblk, k0 = 64 * kb, n0 = 32 * nb;
#pragma unroll 8
    for (int i = 0; i < 32; ++i) { const int kk = 2 * i + (lane >> 5); float v = W[(size_t)(k0 + kk) * N + n0 + (lane & 31)]; if (kscale) v *= kscale[k0 + kk]; scr[kk * 33 + (lane & 31)] = v; }
    asm volatile("s_waitcnt lgkmcnt(0)" ::: "memory");
    const int c = lane & 7;
#pragma unroll
    for (int j = 0; j < 4; ++j) { const int n = (lane >> 3) + 8 * j; const float* s = scr + (8 * c) * 33 + n;
        u32x4 o; o.x = pk2(s[0 * 33], s[1 * 33]); o.y = pk2(s[2 * 33], s[3 * 33]); o.z = pk2(s[4 * 33], s[5 * 33]); o.w = pk2(s[6 * 33], s[7 * 33]);
        *(u32x4*)(WT + (size_t)(row_off + map_row(map, n0 + n)) * K + k0 + 8 * c) = o; }
    asm volatile("s_waitcnt lgkmcnt(0)" ::: "memory");
}

__device__ __forceinline__ void p0_mod(const Params& p, unsigned char* lds, int tid, int wave, int lane, int bid, int G) {
    float* sc = (float*)lds;
    float* red = sc + 16384;
    float* mod = (float*)(p.ws + WS_MOD);
    for (int i = tid; i < 16384; i += NTHREADS) { const float v = p.c[i]; sc[i] = v / (1.f + __expf(-v)); }
    __syncthreads();
    for (int item = bid; item < 384; item += G) {
        const int gc = item * 64 + lane, l = gc / 6144, m = gc - l * 6144;
        const float* wp = p.ada_w + ((size_t)l * 1024 + wave * 128) * 6144 + m;
        const float* sp = sc + wave * 128;
        float acc[16];
#pragma unroll
        for (int b = 0; b < 16; ++b) acc[b] = 0.f;
#pragma unroll 4
        for (int k = 0; k < 128; ++k) { const float w = wp[(size_t)k * 6144];
#pragma unroll
            for (int b = 0; b < 16; ++b) acc[b] = fmaf(w, sp[b * 1024 + k], acc[b]); }
#pragma unroll
        for (int b = 0; b < 16; ++b) red[(wave * 16 + b) * 64 + lane] = acc[b];
        __syncthreads();
        for (int o = tid; o < 1024; o += NTHREADS) { const int b = o >> 6, ci = o & 63; float s = 0.f;
#pragma unroll
            for (int w = 0; w < 8; ++w) s += red[(w * 16 + b) * 64 + ci];
            const int gcc = item * 64 + ci; mod[(size_t)b * 24576 + gcc] = s + p.ada_b[gcc]; }
        __syncthreads();
    }
}

__device__ __forceinline__ void p0_cs(const Params& p, int gtid, int nthr) {
    float* cs = (float*)(p.ws + WS_CS);
    for (int idx = gtid; idx < T * 32; idx += nthr) {
        const int t = idx >> 5, i = idx & 31;
        double inv = 1.0; for (int j = 0; j < i; ++j) inv *= 0.74989420933245582730;
        const double ang = (double)p.pos[t] * inv;
        const double k = __builtin_rint(ang * 0.63661977236758134308);
        double y = __builtin_fma(-k, 1.57079632673412561417e+00, ang); y = __builtin_fma(-k, 6.07710050650619224932e-11, y);
        const double y2 = y * y;
        double sn = -1.0 / 6227020800.0; sn = sn * y2 + 1.0 / 39916800.0; sn = sn * y2 - 1.0 / 362880.0; sn = sn * y2 + 1.0 / 5040.0; sn = sn * y2 - 1.0 / 120.0; sn = sn * y2 + 1.0 / 6.0; sn = y - y * y2 * sn;
        double cn = 1.0 / 87178291200.0; cn = cn * y2 - 1.0 / 479001600.0; cn = cn * y2 + 1.0 / 3628800.0; cn = cn * y2 - 1.0 / 40320.0; cn = cn * y2 + 1.0 / 720.0; cn = cn * y2 - 1.0 / 24.0; cn = cn * y2 + 0.5; cn = 1.0 - y2 * cn;
        const int q = (int)((long long)k & 3);
        const double cc = (q == 0) ? cn : (q == 1) ? -sn : (q == 2) ? -cn : sn;
        const double ss = (q == 0) ? sn : (q == 1) ? cn : (q == 2) ? -sn : -cn;
        *(f32x2*)(cs + (size_t)idx * 2) = (f32x2){(float)cc, (float)ss};
    }
}

__device__ __forceinline__ void p0_weights(const Params& p, unsigned char* lds, int gw, int NGW, int wave, int lane) {
    float* scr = (float*)(lds + wave * 16384);
    bf16* W1T = (bf16*)(p.ws + WS_W1T); bf16* W2T = (bf16*)(p.ws + WS_W2T); bf16* PWT = (bf16*)(p.ws + WS_PWT); bf16* QDT = (bf16*)(p.ws + WS_QDT);
    bf16* QUT = (bf16*)(p.ws + WS_QUT); bf16* AOT = (bf16*)(p.ws + WS_AOT); bf16* KVINT = (bf16*)(p.ws + WS_KVINT); bf16* KVUT = (bf16*)(p.ws + WS_KVUT);
    constexpr int I_W1 = (D / 64) * (FF / 32), I_W2 = (FF / 64) * (D / 32), I_PW = 4 * 8, I_QD = 16 * 16, I_QU = 8 * 48, I_AO = 16 * 32, I_KVIN = 16 * 10, I_KU = 4 * 32;
    constexpr int NITEMS = 4 * I_W1 + 4 * I_W2 + 8 * I_PW + 2 * I_QD + 2 * I_QU + 2 * I_AO + I_KVIN + 2 * I_KU;
    for (int it = gw; it < NITEMS; it += NGW) {
        int r = it;
        if (r < 4 * I_W1) { const int l = r / I_W1; transpose_item(p.w1 + (size_t)l * D * FF, D, FF, W1T + (size_t)l * D * FF, 0, 0, nullptr, scr, r % I_W1, lane); continue; } r -= 4 * I_W1;
        if (r < 4 * I_W2) { const int l = r / I_W2; transpose_item(p.w2 + (size_t)l * D * FF, FF, D, W2T + (size_t)l * D * FF, 0, 0, nullptr, scr, r % I_W2, lane); continue; } r -= 4 * I_W2;
        if (r < 8 * I_PW) { const int g = r / I_PW; transpose_item(p.pool_w + (size_t)g * 65536, 256, 256, PWT + (size_t)g * 65536, 0, 0, nullptr, scr, r % I_PW, lane); continue; } r -= 8 * I_PW;
        if (r < 2 * I_QD) { const int j = r / I_QD; transpose_item(p.q_down + (size_t)j * D * QR, D, QR, QDT + (size_t)j * D * QR, 0, 0, nullptr, scr, r % I_QD, lane); continue; } r -= 2 * I_QD;
        if (r < 2 * I_QU) { const int j = r / I_QU; transpose_item(p.q_up + (size_t)j * QR * 1536, QR, 1536, QUT + (size_t)j * QR * 1536, 0, 1, p.q_norm_g + j * QR, scr, r % I_QU, lane); continue; } r -= 2 * I_QU;
        if (r < 2 * I_AO) { const int j = r / I_AO; transpose_item(p.attn_out + (size_t)j * D * D, D, D, AOT + (size_t)j * D * D, 0, 0, nullptr, scr, r % I_AO, lane); continue; } r -= 2 * I_AO;
        if (r < I_KVIN) { transpose_item(p.kv_in, D, 320, KVINT, 0, 0, nullptr, scr, r, lane); continue; } r -= I_KVIN;
        if (r < I_KU) { transpose_item(p.k_up, KVR, 1024, KVUT, 0, 0, p.kv_norm_g, scr, r, lane); continue; } r -= I_KU;
        transpose_item(p.v_up, KVR, 1024, KVUT, 1024, 0, p.kv_norm_g, scr, r, lane);
    }
    { u32x4* z = (u32x4*)(KVINT + (size_t)320 * D); const int nz = 192 * D / 8;
      for (int i = gw * 64 + lane; i < nz; i += NGW * 64) z[i] = (u32x4){0u, 0u, 0u, 0u}; }
}

__device__ __forceinline__ void prep_rows(const float* z, const float* lng, const float* lnb, const float* modl  , int shi, float* st, bf16* H, bf16* XB, int gw, int NGW, int lane) {
    for (int m = gw; m < T; m += NGW) {
        const int b = m >> 12;
        const f32x4* xr = (const f32x4*)(z + (size_t)m * D) + lane;
        f32x4 v[4]; float s = 0.f;
#pragma unroll
        for (int j = 0; j < 4; ++j) { v[j] = xr[64 * j]; s += (v[j].x + v[j].y) + (v[j].z + v[j].w); }
        const float mean = wave_sum(s) * (1.f / D); float s2 = 0.f;
#pragma unroll
        for (int j = 0; j < 4; ++j) { v[j] = v[j] - mean; s2 += (v[j].x * v[j].x + v[j].y * v[j].y) + (v[j].z * v[j].z + v[j].w * v[j].w); }
        const float rstd = 1.f / sqrtf(wave_sum(s2) * (1.f / D) + LN_EPS);
        if (lane == 0) *(f32x2*)(st + (size_t)m * 2) = (f32x2){mean, rstd};
        const float* shp = modl + (size_t)b * 24576 + shi * 1024; const float* scp = shp + 1024;
        unsigned long long* h8 = (unsigned long long*)(H + (size_t)m * D) + lane;
        unsigned long long* x8 = XB ? (unsigned long long*)(XB + (size_t)m * D) + lane : nullptr;
#pragma unroll
        for (int j = 0; j < 4; ++j) { const int c = 4 * lane + 256 * j;
            const f32x4 g = *(const f32x4*)(lng + c), bb = *(const f32x4*)(lnb + c), sh = *(const f32x4*)(shp + c), sc = *(const f32x4*)(scp + c);
            const f32x4 x = v[j] * rstd * g + bb;
            if (XB) x8[64 * j] = (unsigned long long)pk2(x.x, x.y) | ((unsigned long long)pk2(x.z, x.w) << 32);
            const f32x4 h = x * (sc + 1.f) + sh;
            h8[64 * j] = (unsigned long long)pk2(h.x, h.y) | ((unsigned long long)pk2(h.z, h.w) << 32); }
    }
}
__device__ __forceinline__ void final_ln(const float* z, const float* lng, const float* lnb, float* out, int gw, int NGW, int lane) {
    for (int m = gw; m < T; m += NGW) {
        const f32x4* xr = (const f32x4*)(z + (size_t)m * D) + lane;
        f32x4 v[4]; float s = 0.f;
#pragma unroll
        for (int j = 0; j < 4; ++j) { v[j] = xr[64 * j]; s += (v[j].x + v[j].y) + (v[j].z + v[j].w); }
        const float mean = wave_sum(s) * (1.f / D); float s2 = 0.f;
#pragma unroll
        for (int j = 0; j < 4; ++j) { v[j] = v[j] - mean; s2 += (v[j].x * v[j].x + v[j].y * v[j].y) + (v[j].z * v[j].z + v[j].w * v[j].w); }
        const float rstd = 1.f / sqrtf(wave_sum(s2) * (1.f / D) + LN_EPS);
        f32x4* o = (f32x4*)(out + (size_t)m * D) + lane;
#pragma unroll
        for (int j = 0; j < 4; ++j) { const int c = 4 * lane + 256 * j; o[64 * j] = v[j] * rstd * *(const f32x4*)(lng + c) + *(const f32x4*)(lnb + c); }
    }
}
__device__ __forceinline__ void rms_rows_q(const bf16* CQ, float* rq, int gw, int NGW, int lane) {
    for (int m = gw; m < T; m += NGW) {
        const u32x4 w = *((const u32x4*)(CQ + (size_t)m * QR) + lane); float ss = 0.f;
#pragma unroll
        for (int e = 0; e < 4; ++e) { const float a = __builtin_bit_cast(float, w[e] << 16), b = __builtin_bit_cast(float, w[e] & 0xffff0000u); ss += a * a + b * b; }
        ss = wave_sum(ss);
        if (lane == 0) rq[m] = 1.f / sqrtf(ss * (1.f / QR) + RMS_EPS);
    }
}
__device__ __forceinline__ void kv_rows(const bf16* CKR, const float* cs, float* rkv, bf16* Kf, int gw, int NGW, int lane) {
    for (int m = gw; m < T; m += NGW) {
        const bf16* row = CKR + (size_t)m * 512;
        const u32x2 w = *((const u32x2*)row + lane); float ss = 0.f;
#pragma unroll
        for (int e = 0; e < 2; ++e) { const float a = __builtin_bit_cast(float, w[e] << 16), b = __builtin_bit_cast(float, w[e] & 0xffff0000u); ss += a * a + b * b; }
        ss = wave_sum(ss);
        if (lane == 0) rkv[m] = 1.f / sqrtf(ss * (1.f / KVR) + RMS_EPS);
        if (lane < 32) { const float k1 = bf2f(row[256 + lane]), k2 = bf2f(row[288 + lane]); const f32x2 c = *(const f32x2*)(cs + ((size_t)m * 32 + lane) * 2);
            const bf16 o1 = (bf16)f2bf(k1 * c.x - k2 * c.y), o2 = (bf16)f2bf(k2 * c.x + k1 * c.y);
            bf16* kd = Kf + (size_t)m * 1536 + 128 + lane;
#pragma unroll
            for (int h = 0; h < 8; ++h) { kd[h * 192] = o1; kd[h * 192 + 32] = o2; } }
    }
}

__device__ __forceinline__ void pool_prep(const float* z, bool raw, const float* lng, const float* lnb, const float* modl, float* st, bf16* P, unsigned char* lds, int tid, int wave, int lane, int bid, int G) {
    f32x2* sst = (f32x2*)lds;
    for (int chunk = bid; chunk < T / 64; chunk += G) {
        const int r0 = chunk * 64, seq0 = r0 & ~(S - 1), b = r0 >> 12;
        const int lo = (r0 - 15 > seq0) ? r0 - 15 : seq0;
        if (!raw) {
            for (int rr = lo + wave; rr < r0 + 64; rr += NWAVES) {
                const f32x4* xr = (const f32x4*)(z + (size_t)rr * D) + lane;
                f32x4 v[4]; float s = 0.f;
#pragma unroll
                for (int j = 0; j < 4; ++j) { v[j] = xr[64 * j]; s += (v[j].x + v[j].y) + (v[j].z + v[j].w); }
                const float mean = wave_sum(s) * (1.f / D); float s2 = 0.f;
#pragma unroll
                for (int j = 0; j < 4; ++j) { v[j] = v[j] - mean; s2 += (v[j].x * v[j].x + v[j].y * v[j].y) + (v[j].z * v[j].z + v[j].w * v[j].w); }
                const float rstd = 1.f / sqrtf(wave_sum(s2) * (1.f / D) + LN_EPS);
                if (lane == 0) { sst[rr - (r0 - 15)] = (f32x2){mean, rstd}; if (rr >= r0) *(f32x2*)(st + (size_t)rr * 2) = (f32x2){mean, rstd}; }
            }
        }
        __syncthreads();
        {
            const int cq = tid & 255, rh = tid >> 8, col = 4 * cq, w = 2 << (cq >> 6), t0 = r0 + rh * 32;
            f32x4 lg = (f32x4){1.f, 1.f, 1.f, 1.f}, lb = (f32x4){0.f, 0.f, 0.f, 0.f};
            if (!raw) { lg = *(const f32x4*)(lng + col); lb = *(const f32x4*)(lnb + col); }
            const f32x4 sh = *(const f32x4*)(modl + (size_t)b * 24576 + col), sc1 = *(const f32x4*)(modl + (size_t)b * 24576 + 1024 + col) + 1.f;
            const int us = (t0 - (w - 1) > seq0) ? t0 - (w - 1) : seq0;
            f32x4 Sx = (f32x4){0.f, 0.f, 0.f, 0.f};
#define HVAL(t_, dst) do { f32x4 zz = *(const f32x4*)(z + (size_t)(t_) * D + col); if (!raw) { const f32x2 s_ = sst[(t_) - (r0 - 15)]; zz = (zz - s_.x) * s_.y * lg + lb; } dst = zz * sc1 + sh; } while (0)
            for (int t = us; t < t0 + 32; ++t) {
                f32x4 hv; HVAL(t, hv); Sx = Sx + hv;
                if (t - w >= us) { f32x4 ho; HVAL(t - w, ho); Sx = Sx - ho; }
                if (t >= t0) { const int n = t - seq0 + 1; const float ic = 1.f / (float)(n < w ? n : w);
                    const f32x4 o = Sx * ic - hv;
                    *(u32x2*)(P + (size_t)t * D + col) = (u32x2){pk2(o.x, o.y), pk2(o.z, o.w)}; }
            }
#undef HVAL
        }
        __syncthreads();
    }
}

__device__ __forceinline__ int att_item(int L, int G) {
    if (G != 256) return L;
    const int i = L >> 8, w = L & 255, xcd = w & 7, k = w >> 3, idx = i * 32 + k;
    return (((idx >> 3) * 8 + xcd) << 3) + (idx & 7);
}
__device__ __forceinline__ att::BlockRef att_ref(int L, int pass, const bf16* Q, const bf16* K, const bf16* V, bf16* O) {
    const int bh = L >> 3, x = L & 7, b = bh >> 3, h = bh & 7, qb = pass ? 15 - x : x;
    att::BlockRef r;
    r.Q = Q + ((size_t)b * S + (size_t)qb * 256) * 1536 + h * 192; r.O = O + ((size_t)b * S + (size_t)qb * 256) * 1024 + h * 128;
    r.K = K + (size_t)b * S * 1536 + h * 192; r.V = V + (size_t)b * S * 1024 + h * 128; r.P0 = qb * 256;
    return r;
}
__device__ __forceinline__ void attn_phase(const bf16* Q, const bf16* K, const bf16* V, bf16* O, char* lds, int bid, int G) {
    const int total = NB * NH * 8, stride = G;
    int L = bid; if (L >= total) return;
    int pass = 0;
    att::BlockRef cur = att_ref(att_item(L, G), 0, Q, K, V, O);
    att::Seam Sm;
    att::causal_prime(cur, lds, Sm);
    for (;;) {
        const bool more_pass = pass == 0, more_item = L + stride < total, last = !more_pass && !more_item;
        int passn = pass + 1, Ln = L;
        if (!more_pass) { passn = 0; Ln = more_item ? L + stride : L; }
        const att::BlockRef nxt = last ? cur : att_ref(att_item(Ln, G), passn, Q, K, V, O);
        att::causal_block(cur, nxt, lds, Sm);
        if (last) break;
        cur = nxt; pass = passn; L = Ln;
    }
}

__global__ void __launch_bounds__(NTHREADS, 2) yoco_fwd(Params p_unused) {
    extern __shared__ __attribute__((aligned(16))) unsigned char lds[];
    cg::grid_group grid = cg::this_grid();
#define PH() const __attribute__((address_space(4))) Params* pp_ = (const __attribute__((address_space(4))) Params*)__builtin_amdgcn_kernarg_segment_ptr(); asm volatile("" : "+s"(pp_)); \
             int tid = threadIdx.x; asm volatile("" : "+v"(tid)); int bid = blockIdx.x; asm volatile("" : "+s"(bid)); int G = gridDim.x; asm volatile("" : "+s"(G)); const int lane = tid & 63, wave = __builtin_amdgcn_readfirstlane(tid >> 6), gw = bid * NWAVES + wave, NGW = G * NWAVES; \
             unsigned char* const ws = pp_->ws; float* const Z = pp_->out; (void)lane; (void)gw; (void)NGW; (void)ws; (void)Z; (void)tid
#define WSP(type, off) ((type*)(ws + (off)))
#define XSYNC1() do { const __attribute__((address_space(4))) Params* pq_ = (const __attribute__((address_space(4))) Params*)__builtin_amdgcn_kernarg_segment_ptr(); asm volatile("" : "+s"(pq_)); \
        XcdBarrier b_; b_.bar = (unsigned*)(pq_->ws + WS_CTL); b_.x = xb_xcc_id(); b_.st = (volatile LAS unsigned*)((LAS unsigned char*)lds + MISC_OFF); xcd_barrier(b_); } while (0)
#define GSYNC() do { XSYNC1(); if (DUP_SYNC) XSYNC1(); } while (0)
#define LDSL ((PG8_LAS unsigned char*)lds)
#define MODL (WSP(float, WS_MOD) + (size_t)l * 6144)
#define LNG_PREV (pp_->ln_g + (size_t)(l * 2 - 1) * D)
#define LNB_PREV (pp_->ln_b + (size_t)(l * 2 - 1) * D)
#define LNG0 (pp_->ln_g + (size_t)(l * 2) * D)
#define LNB0 (pp_->ln_b + (size_t)(l * 2) * D)

    { volatile LAS unsigned* misc = (volatile LAS unsigned*)((LAS unsigned char*)lds + MISC_OFF); if (threadIdx.x < 32) misc[threadIdx.x] = 0u; __syncthreads();
      (void)xcd_barrier_post((unsigned*)(p_unused.ws + WS_CTL), misc); }
    { PH(); const Params& p = p_unused;
      p0_mod(p, lds, tid, wave, lane, bid, G);
      p0_cs(p, bid * NTHREADS + tid, G * NTHREADS);
      p0_weights(p, lds, gw, NGW, wave, lane); }
    grid.sync();

    for (int l = 0; l < NL; ++l) {
        if (l < 2) {
            { PH(); const bool raw = (l == 0);
              pool_prep(raw ? pp_->x : Z, raw, LNG_PREV, LNB_PREV, MODL, WSP(float, WS_ST), WSP(bf16, WS_H), lds, tid, wave, lane, bid, G); }
            GSYNC();
            { PH(); const bool raw = (l == 0);
              pg8::Gemm g{WSP(bf16, WS_H), WSP(bf16, WS_PWT) + (size_t)l * 4 * 65536, T, D, 256, D, (size_t)512};
              pg8::StaticOrder So; So.init(T, D, G, bid);
              pg8::EpiRes E{raw ? pp_->x : Z, Z, raw ? nullptr : WSP(float, WS_ST), LNG_PREV, LNB_PREV, MODL + 2 * 1024, pp_->pool_scale + (size_t)l * D, 0, ALPHA};
              pg8::gemm_phase<pg8::EpiRes, pg8::StaticOrder, true, true>(LDSL, g, So, E); }
            GSYNC();
        } else {
            const int j = l - 2;
            { PH(); prep_rows(Z, LNG_PREV, LNB_PREV, MODL, 0, WSP(float, WS_ST), WSP(bf16, WS_H), (j == 0) ? WSP(bf16, WS_XB) : nullptr, gw, NGW, lane); }
            GSYNC();
            if (j == 0) { PH();
              pg8::Gemm g{WSP(bf16, WS_XB), WSP(bf16, WS_KVINT), T, 512, D, D, (size_t)0};
              pg8::StaticOrder So; So.init(T, 512, G, bid);
              pg8::EpiBf16<0> E{WSP(bf16, WS_CKR), 512};
              pg8::gemm_phase<pg8::EpiBf16<0>, pg8::StaticOrder, true, true>(LDSL, g, So, E); }
            { PH();
              pg8::Gemm g{WSP(bf16, WS_H), WSP(bf16, WS_QDT) + (size_t)j * D * QR, T, QR, D, D, (size_t)0};
              pg8::StaticOrder So; So.init(T, QR, G, bid);
              pg8::EpiBf16<0> E{WSP(bf16, WS_CQ), QR};
              pg8::gemm_phase<pg8::EpiBf16<0>, pg8::StaticOrder, true, true>(LDSL, g, So, E); }
            GSYNC();
            { PH(); if (j == 0) kv_rows(WSP(bf16, WS_CKR), WSP(float, WS_CS), WSP(float, WS_RKV), WSP(bf16, WS_K), gw, NGW, lane);
              rms_rows_q(WSP(bf16, WS_CQ), WSP(float, WS_RQ), gw, NGW, lane); }
            GSYNC();
            if (j == 0) { PH();
              pg8::Gemm g{WSP(bf16, WS_CKR), WSP(bf16, WS_KVUT), T, 2048, KVR, 512, (size_t)0};
              pg8::StaticOrder So; So.init(T, 2048, G, bid);
              pg8::EpiHead<0> E{WSP(bf16, WS_K), WSP(bf16, WS_V), WSP(float, WS_RKV), WSP(float, WS_CS)};
              pg8::gemm_phase<pg8::EpiHead<0>, pg8::StaticOrder, true, true>(LDSL, g, So, E); }
            { PH();
              pg8::Gemm g{WSP(bf16, WS_CQ), WSP(bf16, WS_QUT) + (size_t)j * QR * 1536, T, 1536, QR, QR, (size_t)0};
              pg8::StaticOrder So; So.init(T, 1536, G, bid);
              pg8::EpiHead<1> E{WSP(bf16, WS_Q), nullptr, WSP(float, WS_RQ), WSP(float, WS_CS)};
              pg8::gemm_phase<pg8::EpiHead<1>, pg8::StaticOrder, true, true>(LDSL, g, So, E); }
            GSYNC();
#ifndef NO_ATT
            for (int rep = 0; rep < 1 + DUP_ATT; ++rep) { PH(); attn_phase(WSP(bf16, WS_Q), WSP(bf16, WS_K), WSP(bf16, WS_V), WSP(bf16, WS_H), (char*)lds, bid, G); }
#endif
            GSYNC();
            { PH();
              pg8::Gemm g{WSP(bf16, WS_H), WSP(bf16, WS_AOT) + (size_t)j * D * D, T, D, D, D, (size_t)0};
              pg8::StaticOrder So; So.init(T, D, G, bid);
              pg8::EpiRes E{Z, Z, WSP(float, WS_ST), LNG_PREV, LNB_PREV, MODL + 2 * 1024, nullptr, 0, ALPHA};
              pg8::gemm_phase<pg8::EpiRes, pg8::StaticOrder, true, true>(LDSL, g, So, E); }
            GSYNC();
        }
        for (int rep = 0; rep < 1 + DUP_ROWS; ++rep) { PH(); prep_rows(Z, LNG0, LNB0, MODL, 3, WSP(float, WS_ST), WSP(bf16, WS_H), nullptr, gw, NGW, lane); }
        GSYNC();
        for (int half = 0; half < 2; ++half) {
            { PH();
              pg8::Gemm g{WSP(bf16, WS_H) + (size_t)half * HALF_T * D, WSP(bf16, WS_W1T) + (size_t)l * D * FF, HALF_T, FF, D, D, (size_t)0};
              pg8::StaticOrder So; So.init(HALF_T, FF, G, bid);
              pg8::EpiBf16<1> E{WSP(bf16, WS_ACT), FF};
              for (int rep = 0; rep < 1 + DUP_G1; ++rep)
              pg8::gemm_phase<pg8::EpiBf16<1>, pg8::StaticOrder, true, true>(LDSL, g, So, E); }
            GSYNC();
            { PH();
              pg8::Gemm g{WSP(bf16, WS_ACT), WSP(bf16, WS_W2T) + (size_t)l * D * FF, HALF_T, D, FF, FF, (size_t)0};
              pg8::StaticOrder So; So.init(HALF_T, D, G, bid);
              if (DUP_G2 && l < 2) { pg8::EpiRes E2{Z, WSP(float, WS_K), WSP(float, WS_ST), LNG0, LNB0, MODL + 5 * 1024, nullptr, half * HALF_T, ALPHA};
                  pg8::gemm_phase<pg8::EpiRes, pg8::StaticOrder, true, true>(LDSL, g, So, E2); }
              pg8::EpiRes E{Z, Z, WSP(float, WS_ST), LNG0, LNB0, MODL + 5 * 1024, nullptr, half * HALF_T, ALPHA};
              pg8::gemm_phase<pg8::EpiRes, pg8::StaticOrder, true, true>(LDSL, g, So, E); }
            GSYNC();
        }
    }
    { PH(); final_ln(Z, pp_->ln_g + (size_t)7 * D, pp_->ln_b + (size_t)7 * D, Z, gw, NGW, lane); }
}
}

extern "C" void kernel_launch(void* const* d_in, const int* in_sizes, int n_in, void* d_out, int out_size, void* d_ws, size_t ws_size, hipStream_t stream) {
    using namespace mk;
    static int grid = 0;
    if (grid == 0) {
        if (n_in != 19 || in_sizes[0] != T * D || out_size != T * D || ws_size < WS_END) { fprintf(stderr, "kernel_launch: unexpected shapes (n_in %d, in0 %d, out %d, ws %zu)\n", n_in, n_in > 0 ? in_sizes[0] : -1, out_size, ws_size); grid = -1; return; }
        int dev = 0, cus = 0, per_cu = 0;
        (void)hipGetDevice(&dev); (void)hipDeviceGetAttribute(&cus, hipDeviceAttributeMultiprocessorCount, dev);
        if (hipFuncSetAttribute((const void*)yoco_fwd, hipFuncAttributeMaxDynamicSharedMemorySize, LDS_BYTES) != hipSuccess) { fprintf(stderr, "kernel_launch: hipFuncSetAttribute failed\n"); grid = -1; return; }
        if (hipOccupancyMaxActiveBlocksPerMultiprocessor(&per_cu, (const void*)yoco_fwd, NTHREADS, LDS_BYTES) != hipSuccess || per_cu < 1) { fprintf(stderr, "kernel_launch: occupancy query gave %d\n", per_cu); per_cu = 1; }
        (void)hipGetLastError();
        grid = cus * per_cu;
    }
    if (grid < 0) return;
    Params p{};
    p.x = (const float*)d_in[0]; p.c = (const float*)d_in[1]; p.pos = (const int*)d_in[2]; p.ada_w = (const float*)d_in[3]; p.ada_b = (const float*)d_in[4];
    p.ln_g = (const float*)d_in[5]; p.ln_b = (const float*)d_in[6]; p.w1 = (const float*)d_in[7]; p.w2 = (const float*)d_in[8]; p.pool_w = (const float*)d_in[9];
    p.pool_scale = (const float*)d_in[10]; p.q_down = (const float*)d_in[11]; p.q_norm_g = (const float*)d_in[12]; p.q_up = (const float*)d_in[13]; p.attn_out = (const float*)d_in[14];
    p.kv_in = (const float*)d_in[15]; p.kv_norm_g = (const float*)d_in[16]; p.k_up = (const float*)d_in[17]; p.v_up = (const float*)d_in[18];
    p.out = (float*)d_out; p.ws = (unsigned char*)d_ws;
    if (hipMemsetAsync((char*)d_ws + WS_CTL, 0, CTL_BYTES, stream) != hipSuccess) { fprintf(stderr, "kernel_launch: hipMemsetAsync failed\n"); return; }
    void* args[] = {&p};
    const hipError_t e = hipLaunchCooperativeKernel((const void*)yoco_fwd, dim3(grid), dim3(NTHREADS), args, LDS_BYTES, stream);
    if (e != hipSuccess) fprintf(stderr, "kernel_launch: cooperative launch failed: %s (grid %d)\n", hipGetErrorString(e), grid);
}
```
